# Optimizing an MI355X kernel written in HIP

```python
import math
import jax, jax.numpy as jnp
from jax import lax
import numpy as np

D_MODEL = 1024
BATCH = 4
SEQ = 4096
DEPTH = 2

CHUNK = 64
D_MIX = D_MODEL
D_ATTN = D_MIX // 2
D_RG = D_MIX // 4
D_S5 = D_MIX - D_ATTN - D_RG
ATTN_HEAD_DIM = 64
ATTN_HEADS = D_ATTN // ATTN_HEAD_DIM
N_PREV_CHUNKS = 8
BAND = (N_PREV_CHUNKS + 1) * CHUNK
REL_CLIP = 128
RG_CONV_WIDTH = 4
RG_BLOCKS = 4
RG_BLOCK_DIM = D_RG // RG_BLOCKS
RG_C = 8.0
S5_GROUP_DIM = 16
S5_GROUPS = D_S5 // S5_GROUP_DIM
S5_STATE = 64
D_IN = 3 * D_ATTN + 2 * D_RG + D_S5
FFN_DIM = 2816
N_EXPERTS = 8
TOP_K = 2
EXPERT_DIM = 2816
EXPERT_BLOCK = 128
N_DENSE = (DEPTH + 1) // 2
N_MOE = DEPTH // 2
EPS = 1e-6

kernel_name = "hybrid_chunk_attn_rglru_s5_moe"


def _rmsnorm(x, g):
    xf = x.astype(jnp.float32)
    var = jnp.mean(xf * xf, axis=-1, keepdims=True)
    return (xf * lax.rsqrt(var + EPS) * g.astype(jnp.float32)).astype(x.dtype)


def _linear_scan(a, b):
    def op(c1, c2):
        a1, b1 = c1
        a2, b2 = c2
        return a1 * a2, a2 * b1 + b2
    return lax.associative_scan(op, (a, b), axis=1)[1]


def _chunked_attention(q, k, v, rel_bias):
    b, l, h, dh = q.shape
    nc = l // CHUNK
    qc = q.reshape(b, nc, CHUNK, h, dh)
    pad = ((0, 0), (N_PREV_CHUNKS, 0), (0, 0), (0, 0), (0, 0))
    kp = jnp.pad(k.reshape(b, nc, CHUNK, h, dh), pad)
    vp = jnp.pad(v.reshape(b, nc, CHUNK, h, dh), pad)
    band_idx = jnp.arange(nc)[:, None] + jnp.arange(N_PREV_CHUNKS + 1)[None, :]
    kb = kp[:, band_idx].reshape(b, nc, BAND, h, dh)
    vb = vp[:, band_idx].reshape(b, nc, BAND, h, dh)
    s = jnp.einsum('bcqhd,bckhd->bhcqk', qc, kb).astype(jnp.float32) * (dh ** -0.5)
    qpos = jnp.arange(CHUNK)[:, None] + N_PREV_CHUNKS * CHUNK
    kpos = jnp.arange(BAND)[None, :]
    rel = jnp.clip(qpos - kpos, -REL_CLIP, REL_CLIP) + REL_CLIP
    bias = rel_bias.astype(jnp.float32)[:, rel]
    key_pos = jnp.arange(nc)[:, None] * CHUNK + jnp.arange(BAND)[None, :] - N_PREV_CHUNKS * CHUNK
    valid = key_pos >= 0
    s = s + bias[:, None]
    s = jnp.where(valid[None, None, :, None, :], s, -1e30)
    p = jax.nn.softmax(s, axis=-1).astype(v.dtype)
    o = jnp.einsum('bhcqk,bckhd->bcqhd', p, vb)
    return o.reshape(b, l, h * dh)


def _rglru_branch(xr, gate, conv_w, conv_b, wx, bx, wa, ba, lam):
    b, l, c = xr.shape
    xc = lax.conv_general_dilated(
        xr, conv_w[:, None, :].astype(xr.dtype), window_strides=(1,),
        padding=[(RG_CONV_WIDTH - 1, 0)], dimension_numbers=('NWC', 'WIO', 'NWC'),
        feature_group_count=c) + conv_b.astype(xr.dtype)
    xf = xc.astype(jnp.float32)
    xblk = xf.reshape(b, l, RG_BLOCKS, RG_BLOCK_DIM)
    gx = jax.nn.sigmoid(jnp.einsum('blhi,hij->blhj', xblk, wx.astype(jnp.float32)).reshape(b, l, c)
                        + bx.astype(jnp.float32))
    ga = jax.nn.sigmoid(jnp.einsum('blhi,hij->blhj', xblk, wa.astype(jnp.float32)).reshape(b, l, c)
                        + ba.astype(jnp.float32))
    log_a = -RG_C * ga * jax.nn.softplus(-lam.astype(jnp.float32))
    a = jnp.exp(log_a)
    mult = jnp.sqrt(-jnp.expm1(2.0 * log_a))
    hseq = _linear_scan(a, mult * gx * xf)
    y = hseq * jax.nn.gelu(gate.astype(jnp.float32))
    return y.astype(xr.dtype)


def _s5_branch(u, a_re, a_im, log_dt, b_re, b_im, c_re, c_im, d, w_glu):
    bsz, l, _ = u.shape
    uf = u.astype(jnp.float32).reshape(bsz, l, S5_GROUPS, S5_GROUP_DIM)
    A = lax.complex(a_re.astype(jnp.float32), a_im.astype(jnp.float32))
    dt = jnp.exp(log_dt.astype(jnp.float32))[:, None]
    A_bar = jnp.exp(A * dt)
    Bm = lax.complex(b_re.astype(jnp.float32), b_im.astype(jnp.float32))
    Cm = lax.complex(c_re.astype(jnp.float32), c_im.astype(jnp.float32))
    B_bar = ((A_bar - 1.0) / A)[..., None] * Bm
    Bu = jnp.einsum('blgc,gpc->blgp', uf.astype(jnp.complex64), B_bar)
    A_seq = jnp.broadcast_to(A_bar, Bu.shape)
    states = _linear_scan(A_seq, Bu)
    y = jnp.real(jnp.einsum('blgp,gcp->blgc', states, Cm)) \
        + d.astype(jnp.float32).reshape(S5_GROUPS, S5_GROUP_DIM) * uf
    y = jax.nn.gelu(y.reshape(bsz, l, D_S5))
    y = y * jax.nn.sigmoid(y @ w_glu.astype(jnp.float32))
    return y.astype(u.dtype)


def _swiglu(h, w1, w3, w2):
    return (jax.nn.silu(h @ w1) * (h @ w3)) @ w2


def _moe(x2, router, w1, w3, w2):
    n, dm = x2.shape
    logits = x2.astype(jnp.float32) @ router.astype(jnp.float32)
    top_logit, top_e = lax.top_k(logits, TOP_K)
    gates = jax.nn.softmax(top_logit, axis=-1)
    flat_e = top_e.reshape(-1)
    flat_tok = jnp.repeat(jnp.arange(n, dtype=jnp.int32), TOP_K)
    flat_g = gates.reshape(-1)
    order = jnp.argsort(flat_e)
    se, st, sg = flat_e[order], flat_tok[order], flat_g[order]
    counts = jnp.zeros((N_EXPERTS,), jnp.int32).at[flat_e].add(1)
    starts = jnp.cumsum(counts) - counts
    pcounts = (counts + EXPERT_BLOCK - 1) // EXPERT_BLOCK * EXPERT_BLOCK
    pends = jnp.cumsum(pcounts)
    pstarts = pends - pcounts
    n_assign = n * TOP_K
    rank = jnp.arange(n_assign, dtype=jnp.int32) - starts[se]
    dest = pstarts[se] + rank
    n_pad = (n_assign + EXPERT_BLOCK - 1) // EXPERT_BLOCK * EXPERT_BLOCK + N_EXPERTS * EXPERT_BLOCK
    n_blocks = n_pad // EXPERT_BLOCK
    buf_tok = jnp.full((n_pad,), n, jnp.int32).at[dest].set(st)
    buf_g = jnp.zeros((n_pad,), jnp.float32).at[dest].set(sg)
    blk_start = jnp.arange(n_blocks, dtype=jnp.int32) * EXPERT_BLOCK
    blk_e = jnp.clip(jnp.searchsorted(pends, blk_start, side='right'), 0, N_EXPERTS - 1)
    x_pad = jnp.concatenate([x2, jnp.zeros((1, dm), x2.dtype)], axis=0)
    xb = x_pad[buf_tok].reshape(n_blocks, EXPERT_BLOCK, dm)

    def expert_block(args):
        xblk, e = args
        return _swiglu(xblk, w1[e], w3[e], w2[e])

    yb = lax.map(expert_block, (xb, blk_e)).reshape(n_pad, dm)
    yb = yb * buf_g[:, None].astype(yb.dtype)
    out = jnp.zeros((n + 1, dm), x2.dtype).at[buf_tok].add(yb)
    return out[:n]


def setup_inputs(seed: int = 0) -> dict:
    key = jax.random.key(seed)
    ks = iter(jax.random.split(key, 40))

    def nrm(shape, scale):
        return jax.random.normal(next(ks), shape, jnp.float32) * scale

    def gain(shape):
        return 1.0 + nrm(shape, 0.02)

    x = nrm((BATCH, SEQ, D_MODEL), 1.0)
    norm_mix_g = gain((DEPTH, D_MODEL))
    w_in = nrm((DEPTH, D_MODEL, D_IN), D_MODEL ** -0.5)
    attn_rel_bias = nrm((DEPTH, ATTN_HEADS, 2 * REL_CLIP + 1), 0.1)
    rg_conv_w = nrm((DEPTH, RG_CONV_WIDTH, D_RG), RG_CONV_WIDTH ** -0.5)
    rg_conv_b = nrm((DEPTH, D_RG), 0.01)
    rg_wx = nrm((DEPTH, RG_BLOCKS, RG_BLOCK_DIM, RG_BLOCK_DIM), RG_BLOCK_DIM ** -0.5)
    rg_bx = nrm((DEPTH, D_RG), 0.01)
    rg_wa = nrm((DEPTH, RG_BLOCKS, RG_BLOCK_DIM, RG_BLOCK_DIM), RG_BLOCK_DIM ** -0.5)
    rg_ba = nrm((DEPTH, D_RG), 0.01)
    a_pow = jax.random.uniform(next(ks), (DEPTH, D_RG), jnp.float32, 0.9, 0.999)
    a0 = a_pow ** (1.0 / RG_C)
    rg_lambda = jnp.log(a0) - jnp.log1p(-a0)
    s5_a_re = -0.5 + nrm((DEPTH, S5_GROUPS, S5_STATE), 0.01)
    s5_a_im = math.pi * jnp.arange(S5_STATE, dtype=jnp.float32) + nrm((DEPTH, S5_GROUPS, S5_STATE), 0.01)
    s5_log_dt = jax.random.uniform(next(ks), (DEPTH, S5_GROUPS), jnp.float32,
                                   math.log(1e-3), math.log(1e-1))
    s5_b_re = nrm((DEPTH, S5_GROUPS, S5_STATE, S5_GROUP_DIM), (2 * S5_GROUP_DIM) ** -0.5)
    s5_b_im = nrm((DEPTH, S5_GROUPS, S5_STATE, S5_GROUP_DIM), (2 * S5_GROUP_DIM) ** -0.5)
    s5_c_re = nrm((DEPTH, S5_GROUPS, S5_GROUP_DIM, S5_STATE), S5_STATE ** -0.5)
    s5_c_im = nrm((DEPTH, S5_GROUPS, S5_GROUP_DIM, S5_STATE), S5_STATE ** -0.5)
    s5_d = nrm((DEPTH, D_S5), 1.0)
    s5_w_glu = nrm((DEPTH, D_S5, D_S5), D_S5 ** -0.5)
    g_group = gain((DEPTH, D_MIX))
    w_out = nrm((DEPTH, D_MIX, D_MODEL), D_MIX ** -0.5)
    norm_ffn_g = gain((DEPTH, D_MODEL))
    ffn_w1 = nrm((N_DENSE, D_MODEL, FFN_DIM), D_MODEL ** -0.5)
    ffn_w3 = nrm((N_DENSE, D_MODEL, FFN_DIM), D_MODEL ** -0.5)
    ffn_w2 = nrm((N_DENSE, FFN_DIM, D_MODEL), FFN_DIM ** -0.5)
    moe_router = nrm((N_MOE, D_MODEL, N_EXPERTS), D_MODEL ** -0.5)
    moe_w1 = nrm((N_MOE, N_EXPERTS, D_MODEL, EXPERT_DIM), D_MODEL ** -0.5)
    moe_w3 = nrm((N_MOE, N_EXPERTS, D_MODEL, EXPERT_DIM), D_MODEL ** -0.5)
    moe_w2 = nrm((N_MOE, N_EXPERTS, EXPERT_DIM, D_MODEL), EXPERT_DIM ** -0.5)
    final_norm_g = gain((D_MODEL,))
    return {
        "x": x, "norm_mix_g": norm_mix_g, "w_in": w_in, "attn_rel_bias": attn_rel_bias,
        "rg_conv_w": rg_conv_w, "rg_conv_b": rg_conv_b, "rg_wx": rg_wx, "rg_bx": rg_bx,
        "rg_wa": rg_wa, "rg_ba": rg_ba, "rg_lambda": rg_lambda,
        "s5_a_re": s5_a_re, "s5_a_im": s5_a_im, "s5_log_dt": s5_log_dt,
        "s5_b_re": s5_b_re, "s5_b_im": s5_b_im, "s5_c_re": s5_c_re, "s5_c_im": s5_c_im,
        "s5_d": s5_d, "s5_w_glu": s5_w_glu, "g_group": g_group, "w_out": w_out,
        "norm_ffn_g": norm_ffn_g, "ffn_w1": ffn_w1, "ffn_w3": ffn_w3, "ffn_w2": ffn_w2,
        "moe_router": moe_router, "moe_w1": moe_w1, "moe_w3": moe_w3, "moe_w2": moe_w2,
        "final_norm_g": final_norm_g,
    }


def reference(x, norm_mix_g, w_in, attn_rel_bias, rg_conv_w, rg_conv_b, rg_wx, rg_bx, rg_wa, rg_ba,
              rg_lambda, s5_a_re, s5_a_im, s5_log_dt, s5_b_re, s5_b_im, s5_c_re, s5_c_im, s5_d,
              s5_w_glu, g_group, w_out, norm_ffn_g, ffn_w1, ffn_w3, ffn_w2, moe_router, moe_w1,
              moe_w3, moe_w2, final_norm_g):
    bsz, l, dm = x.shape
    split_at = [D_ATTN, 2 * D_ATTN, 3 * D_ATTN, 3 * D_ATTN + D_RG, 3 * D_ATTN + 2 * D_RG]
    for layer in range(DEPTH):
        u = _rmsnorm(x, norm_mix_g[layer])
        proj = u @ w_in[layer]
        q, k, v, xr, gate, us = jnp.split(proj, split_at, axis=-1)
        hs = (bsz, l, ATTN_HEADS, ATTN_HEAD_DIM)
        y_attn = _chunked_attention(q.reshape(hs), k.reshape(hs), v.reshape(hs), attn_rel_bias[layer])
        y_rg = _rglru_branch(xr, gate, rg_conv_w[layer], rg_conv_b[layer], rg_wx[layer], rg_bx[layer],
                             rg_wa[layer], rg_ba[layer], rg_lambda[layer])
        y_s5 = _s5_branch(us, s5_a_re[layer], s5_a_im[layer], s5_log_dt[layer], s5_b_re[layer],
                          s5_b_im[layer], s5_c_re[layer], s5_c_im[layer], s5_d[layer], s5_w_glu[layer])
        gg = g_group[layer]
        mixed = jnp.concatenate([
            _rmsnorm(y_attn, gg[:D_ATTN]),
            _rmsnorm(y_rg, gg[D_ATTN:D_ATTN + D_RG]),
            _rmsnorm(y_s5, gg[D_ATTN + D_RG:]),
        ], axis=-1)
        x = x + mixed @ w_out[layer]
        h = _rmsnorm(x, norm_ffn_g[layer])
        idx = layer // 2
        if layer % 2 == 0:
            y = _swiglu(h, ffn_w1[idx], ffn_w3[idx], ffn_w2[idx])
        else:
            y = _moe(h.reshape(-1, dm), moe_router[idx], moe_w1[idx], moe_w3[idx],
                     moe_w2[idx]).reshape(bsz, l, dm)
        x = x + y
    return _rmsnorm(x, final_norm_g)
```

```cpp
#include <hip/hip_runtime.h>
#include <cstdio>
#include <cstdint>
#include <cmath>

#ifndef MK_N_LAUNCHES
#define MK_N_LAUNCHES 1
#endif

constexpr int BATCH = 4, SEQ = 4096, D = 1024, M = BATCH * SEQ;
constexpr int DEPTH = 2;
constexpr int CHUNK = 64, NCH = SEQ / CHUNK, NUNIT = BATCH * NCH;
constexpr int D_ATTN = 512, D_RG = 256, D_S5 = 256, D_IN = 2304;
constexpr int NHEAD = 8, HD = 64;
constexpr int FF = 2816, NE = 8;
constexpr int S5G = 16, S5C = 16, S5P = 64;
constexpr float EPS = 1e-6f;
constexpr float LOG2E = 1.4426950408889634f;
constexpr float QSCALE = 0.125f * LOG2E;
constexpr int PMAX = 2 * M + NE * 256;
constexpr int PTILES = PMAX / 256;

#define GAS __attribute__((address_space(1)))
#define LAS __attribute__((address_space(3)))
typedef unsigned short bf16_t;
typedef short bf16x8 __attribute__((ext_vector_type(8)));
typedef float f32x4 __attribute__((ext_vector_type(4)));
typedef float f32x2 __attribute__((ext_vector_type(2)));
typedef float f32x16 __attribute__((ext_vector_type(16)));
typedef unsigned u32x4 __attribute__((ext_vector_type(4)));
typedef unsigned u32x2 __attribute__((ext_vector_type(2)));
typedef GAS unsigned gu32;
#define RLX_AGENT __ATOMIC_RELAXED, __HIP_MEMORY_SCOPE_AGENT
#define LDS_WAIT() asm volatile("s_waitcnt lgkmcnt(0)" ::: "memory")
#define VM_WAIT() asm volatile("s_waitcnt vmcnt(0)" ::: "memory")

__device__ __forceinline__ unsigned f2bf(float f) { unsigned u = __builtin_bit_cast(unsigned, f); return (u + 0x7fffu + ((u >> 16) & 1u)) >> 16; }
__device__ __forceinline__ unsigned pk2(float lo, float hi) { return f2bf(lo) | (f2bf(hi) << 16); }
__device__ __forceinline__ float bf2f(unsigned short h) { return __builtin_bit_cast(float, (unsigned)h << 16); }
__device__ __forceinline__ float bflo(unsigned w) { return __builtin_bit_cast(float, w << 16); }
__device__ __forceinline__ float bfhi(unsigned w) { return __builtin_bit_cast(float, w & 0xffff0000u); }
__device__ __forceinline__ float fexp2(float x) { return __builtin_amdgcn_exp2f(x); }
__device__ __forceinline__ float frcp(float x) { return __builtin_amdgcn_rcpf(x); }
__device__ __forceinline__ float sigmoidf_(float x) { return frcp(1.0f + fexp2(-x * LOG2E)); }
__device__ __forceinline__ float gelu_tanh(float x) {
    const float z = 0.7978845608028654f * (x + 0.044715f * x * x * x);
    return x * frcp(1.0f + fexp2(-2.0f * LOG2E * z));
}
__device__ __forceinline__ float wave_sum(float v) {
#pragma unroll
    for (int o = 1; o < 64; o <<= 1) v += __shfl_xor(v, o);
    return v;
}

namespace pg8 {
#define PG8_LAS __attribute__((address_space(3)))
constexpr int BM = 256, BK = 64, HALF = 128, HTB = HALF * BK * 2  , STAGE_BYTES = 8 * HTB, NXCD = 8, WGM = 8;
constexpr int MAXU = 12;

__host__ __device__ __forceinline__ int lds_byte(int r, int c) { const int st = (r >> 4) * 2 + (c >> 5), rr = r & 15, cc = c & 31, ob = rr * 64 + cc * 2; return st * 1024 + (ob ^ (((ob >> 9) & 1) << 5)); }
__host__ __device__ __forceinline__ void stage_rc(int b, int& R, int& C) { const int st = b / 1024, sb = b % 1024, swz = sb ^ (((sb >> 9) & 1) << 5); R = (st >> 1) * 16 + swz / 64; C = (st & 1) * 32 + (swz % 64) / 2; }
__host__ __device__ __forceinline__ int perm32(int rho) { const int n = rho >> 4, i = rho & 15; return 8 * (i >> 2) + 4 * n + (i & 3); }

struct Unit { int pm, pn; };
struct Gemm { const bf16_t* A; const bf16_t* Bt; int N, K; const int* rowtok; const int* tile_e; size_t estride; };

struct StaticOrder {
    int nM, nN, nwg, G, c;
    __host__ __device__ void init(int nM_, int N, int G_, int c_) { nM = nM_; nN = N / BM; nwg = nM * nN; G = G_; c = c_; }
    __host__ __device__ bool next(int i, Unit& u) const {
        const long L = (long)i * G + c; if (L >= nwg) return false;
        int wgid = (int)L; { const int q = nwg / NXCD, r = nwg % NXCD, xcd = wgid % NXCD, off = wgid / NXCD; wgid = (xcd < r ? xcd * (q + 1) : r * (q + 1) + (xcd - r) * q) + off; }
        const int nig = WGM * nN, gid = wgid / nig, fm = gid * WGM, gsz = (nM - fm) < WGM ? (nM - fm) : WGM;
        u.pm = fm + ((wgid % nig) % gsz); u.pn = (wgid % nig) / gsz; return true;
    }
};

__device__ __forceinline__ unsigned cvt_pk_bf16(float lo, float hi) { unsigned r; asm volatile("v_cvt_pk_bf16_f32 %0, %1, %2" : "=v"(r) : "v"(lo), "v"(hi)); return r; }


struct EpiProj {
    static constexpr bool PERM = true, AFTER_DRAIN = false;
    bf16_t* QK; bf16_t* VT; bf16_t* RGS;
    __device__ __forceinline__ void operator()(const f32x4 (&acc)[2][2][4][2], const Unit& u, int wr, int wc, int fr, int fq) const {
        const int row0 = u.pm * BM + wr * 64 + fr;
        if (u.pn < 4 || u.pn >= 6) {
            bf16_t* base; int ldc, colt; float sc = 1.f;
            if (u.pn < 4) { base = QK; ldc = 1024; colt = u.pn * BM; if (u.pn < 2) sc = QSCALE; } else { base = RGS; ldc = 768; colt = (u.pn - 6) * BM; }
            const int col0 = colt + wc * 32 + 8 * fq;
#pragma unroll
            for (int ai = 0; ai < 2; ++ai)
#pragma unroll
                for (int m = 0; m < 4; ++m) { bf16_t* rowp = base + (size_t)(row0 + ai * HALF + m * 16) * ldc + col0;
#pragma unroll
                    for (int bj = 0; bj < 2; ++bj) { const f32x4 v0 = acc[ai][bj][m][0] * sc, v1 = acc[ai][bj][m][1] * sc;
                        u32x4 w; w.x = cvt_pk_bf16(v0[0], v0[1]); w.y = cvt_pk_bf16(v0[2], v0[3]); w.z = cvt_pk_bf16(v1[0], v1[1]); w.w = cvt_pk_bf16(v1[2], v1[3]);
                        *(u32x4*)(rowp + bj * HALF) = w; } }
        } else {
            const int ch0 = (u.pn - 4) * BM + wc * 32 + 8 * fq;
#pragma unroll
            for (int ai = 0; ai < 2; ++ai)
#pragma unroll
                for (int m = 0; m < 4; ++m) { const int r = row0 + ai * HALF + m * 16; const int b = r >> 12, t = r & (SEQ - 1);
                    bf16_t* vp = VT + ((size_t)b * D_ATTN + ch0) * SEQ + t;
#pragma unroll
                    for (int bj = 0; bj < 2; ++bj)
#pragma unroll
                        for (int n = 0; n < 2; ++n)
#pragma unroll
                            for (int j = 0; j < 4; ++j) vp[(size_t)(bj * HALF + 4 * n + j) * SEQ] = (bf16_t)f2bf(acc[ai][bj][m][n][j]); }
        }
    }
};
struct EpiResid {
    static constexpr bool PERM = false, AFTER_DRAIN = false;
    const float* base; float* out; int ldc;
    __device__ __forceinline__ void operator()(const f32x4 (&acc)[2][2][4][2], const Unit& u, int wr, int wc, int fr, int fq) const {
        const int row0 = u.pm * BM + wr * 64 + fr, col0 = u.pn * BM + wc * 32 + 4 * fq;
#pragma unroll
        for (int ai = 0; ai < 2; ++ai)
#pragma unroll
            for (int m = 0; m < 4; ++m) { const size_t off = (size_t)(row0 + ai * HALF + m * 16) * ldc + col0;
#pragma unroll
                for (int bj = 0; bj < 2; ++bj)
#pragma unroll
                    for (int n = 0; n < 2; ++n) { const f32x4 bs = *(const f32x4*)(base + off + bj * HALF + n * 16); *(f32x4*)(out + off + bj * HALF + n * 16) = bs + acc[ai][bj][m][n]; } }
    }
};
struct EpiSwiGLU {
    static constexpr bool PERM = true, AFTER_DRAIN = false;
    bf16_t* O; int ldc;
    __device__ __forceinline__ void operator()(const f32x4 (&acc)[2][2][4][2], const Unit& u, int wr, int wc, int fr, int fq) const {
        const int row0 = u.pm * BM + wr * 64 + fr, col0 = u.pn * HALF + wc * 32 + 8 * fq;
#pragma unroll
        for (int ai = 0; ai < 2; ++ai)
#pragma unroll
            for (int m = 0; m < 4; ++m) { bf16_t* rowp = O + (size_t)(row0 + ai * HALF + m * 16) * ldc + col0;
                float v[8];
#pragma unroll
                for (int n = 0; n < 2; ++n)
#pragma unroll
                    for (int j = 0; j < 4; ++j) { const float a = acc[ai][0][m][n][j], b = acc[ai][1][m][n][j]; v[4 * n + j] = a * sigmoidf_(a) * b; }
                u32x4 w; w.x = cvt_pk_bf16(v[0], v[1]); w.y = cvt_pk_bf16(v[2], v[3]); w.z = cvt_pk_bf16(v[4], v[5]); w.w = cvt_pk_bf16(v[6], v[7]);
                *(u32x4*)rowp = w; }
    }
};
struct EpiBf16 {
    static constexpr bool PERM = true, AFTER_DRAIN = false;
    bf16_t* O; int ldc;
    __device__ __forceinline__ void operator()(const f32x4 (&acc)[2][2][4][2], const Unit& u, int wr, int wc, int fr, int fq) const {
        const int row0 = u.pm * BM + wr * 64 + fr, col0 = u.pn * BM + wc * 32 + 8 * fq;
#pragma unroll
        for (int ai = 0; ai < 2; ++ai)
#pragma unroll
            for (int m = 0; m < 4; ++m) { bf16_t* rowp = O + (size_t)(row0 + ai * HALF + m * 16) * ldc + col0;
#pragma unroll
                for (int bj = 0; bj < 2; ++bj) { const f32x4 v0 = acc[ai][bj][m][0], v1 = acc[ai][bj][m][1];
                    u32x4 w; w.x = cvt_pk_bf16(v0[0], v0[1]); w.y = cvt_pk_bf16(v0[2], v0[3]); w.z = cvt_pk_bf16(v1[0], v1[1]); w.w = cvt_pk_bf16(v1[2], v1[3]);
                    *(u32x4*)(rowp + bj * HALF) = w; } }
    }
};
struct EpiGLU {
    static constexpr bool PERM = true, AFTER_DRAIN = true;
    const bf16_t* Y; bf16_t* MIXO; const float* gg;
    __device__ __forceinline__ void fused(f32x4 (&acc)[2][2][4][2], const Unit& u, int wr, int wc, int fr, int fq, PG8_LAS unsigned char* lds, int wid, int lane) const {
        PG8_LAS float* P = (PG8_LAS float*)lds;
        const int row0 = u.pm * BM + wr * 64 + fr, col0 = wc * 32 + 8 * fq;
#pragma unroll
        for (int ai = 0; ai < 2; ++ai)
#pragma unroll
            for (int m = 0; m < 4; ++m) { const bf16_t* yp = Y + (size_t)(row0 + ai * HALF + m * 16) * 256 + col0; float ss = 0.f;
#pragma unroll
                for (int bj = 0; bj < 2; ++bj) { const u32x4 yw = *(const u32x4*)(yp + bj * HALF);
                    const float yv[8] = {bflo(yw.x), bfhi(yw.x), bflo(yw.y), bfhi(yw.y), bflo(yw.z), bfhi(yw.z), bflo(yw.w), bfhi(yw.w)};
#pragma unroll
                    for (int n = 0; n < 2; ++n)
#pragma unroll
                        for (int j = 0; j < 4; ++j) { const float o = yv[4 * n + j] * sigmoidf_(acc[ai][bj][m][n][j]); acc[ai][bj][m][n][j] = o; ss += o * o; } }
                ss += __shfl_xor(ss, 16); ss += __shfl_xor(ss, 32);
                if (fq == 0) P[(ai * HALF + wr * 64 + m * 16 + fr) * 4 + wc] = ss; }
        asm volatile("s_waitcnt lgkmcnt(0)" ::: "memory"); __builtin_amdgcn_s_barrier(); asm volatile("" ::: "memory");
        f32x4 gv[2][2];
#pragma unroll
        for (int bj = 0; bj < 2; ++bj)
#pragma unroll
            for (int n = 0; n < 2; ++n) gv[bj][n] = *(const f32x4*)(gg + col0 + bj * HALF + 4 * n);
#pragma unroll
        for (int ai = 0; ai < 2; ++ai)
#pragma unroll
            for (int m = 0; m < 4; ++m) { const int rl = ai * HALF + wr * 64 + m * 16 + fr; const f32x4 p = *(const PG8_LAS f32x4*)(P + rl * 4);
                const float rstd = __builtin_amdgcn_rsqf(((p[0] + p[1]) + (p[2] + p[3])) * (1.0f / 256.0f) + EPS);
                bf16_t* rowp = MIXO + (size_t)(u.pm * BM + rl) * 1024 + col0;
#pragma unroll
                for (int bj = 0; bj < 2; ++bj) { const f32x4 v0 = acc[ai][bj][m][0] * rstd * gv[bj][0], v1 = acc[ai][bj][m][1] * rstd * gv[bj][1];
                    u32x4 w; w.x = cvt_pk_bf16(v0[0], v0[1]); w.y = cvt_pk_bf16(v0[2], v0[3]); w.z = cvt_pk_bf16(v1[0], v1[1]); w.w = cvt_pk_bf16(v1[2], v1[3]);
                    *(u32x4*)(rowp + bj * HALF) = w; } }
    }
};

template <class Epi, bool ALIGN_EPI, bool GATHER>
__device__ __forceinline__ void gemm_phase(PG8_LAS unsigned char* lds, PG8_LAS int* tab, const Gemm g, const StaticOrder& S, const Epi& E) {
    int tid_ = threadIdx.x; asm volatile("" : "+v"(tid_));
    const int tid = tid_, wid = __builtin_amdgcn_readfirstlane(tid >> 6), lane = tid & 63, wr = wid >> 2, wc = wid & 3, fr = lane & 15, fq = lane >> 4;
    const int K = g.K, nt = K / BK;
    int sR[2], sC[2];
    unsigned voffA[2], voffB[2];
#pragma unroll
    for (int i = 0; i < 2; ++i) { int R, C; stage_rc(tid * 16 + i * 8192, R, C); sR[i] = R; sC[i] = C; const int Rb = Epi::PERM ? ((R & ~31) + perm32(R & 31)) : R;
        voffA[i] = (unsigned)(R * K + C) * 2u; voffB[i] = (unsigned)(Rb * K + C) * 2u; }
    const size_t kstep = (size_t)(BK * 2);
    const size_t hstep = (size_t)HALF * K * 2;
    const size_t tstep = 2 * hstep;
    const size_t hstepA = GATHER ? 0 : hstep;
    const unsigned ldsw = (unsigned)wid * 1024u;
    const int aoff = lds_byte(wr * 64 + fr, fq * 8), boff = lds_byte(wc * 32 + fr, fq * 8);
    const bool use_e = (g.tile_e != nullptr);
    if (GATHER || use_e) {
        Unit uu;
        for (int i = 0; i < MAXU && S.next(i, uu); ++i) {
            if (tid == 0) tab[i] = use_e ? (int)__hip_atomic_load((const unsigned*)g.tile_e + uu.pm, RLX_AGENT) : 0;
            if (GATHER && tid < 256) tab[16 + 256 * i + tid] = (int)__hip_atomic_load((const unsigned*)g.rowtok + uu.pm * 256 + tid, RLX_AGENT);
        }
        asm volatile("s_waitcnt vmcnt(0) lgkmcnt(0)" ::: "memory"); __syncthreads();
    }
#define PG8_SA(b, h) (((b) * 2 + (h)) * HTB)
#define PG8_SB(b, h) ((4 + (b) * 2 + (h)) * HTB)
#define PG8_STAGE(bufoff, gbase, voff) do { _Pragma("unroll") for (int _i = 0; _i < 2; ++_i) \
        __builtin_amdgcn_global_load_lds((const unsigned*)((const char*)(gbase) + (voff)[_i]), (PG8_LAS unsigned*)(lds + (bufoff) + ldsw + _i * 8192), 16, 0, 0); } while (0)
#define PG8_LDA(dst, b, h) do { _Pragma("unroll") for (int m = 0; m < 4; ++m) _Pragma("unroll") for (int k = 0; k < 2; ++k) dst[m][k] = *(const PG8_LAS bf16x8*)(lds + PG8_SA(b, h) + aoff + m * 2048 + k * 1024); } while (0)
#define PG8_LDB(dst, b, h) do { _Pragma("unroll") for (int n = 0; n < 2; ++n) _Pragma("unroll") for (int k = 0; k < 2; ++k) dst[n][k] = *(const PG8_LAS bf16x8*)(lds + PG8_SB(b, h) + boff + n * 2048 + k * 1024); } while (0)
#define PG8_MMA(ai, bj, At, Bt) do { __builtin_amdgcn_s_setprio(1); _Pragma("unroll") for (int m = 0; m < 4; ++m) _Pragma("unroll") for (int n = 0; n < 2; ++n) _Pragma("unroll") for (int k = 0; k < 2; ++k) \
        acc[ai][bj][m][n] = __builtin_amdgcn_mfma_f32_16x16x32_bf16(Bt[n][k], At[m][k], acc[ai][bj][m][n], 0, 0, 0); __builtin_amdgcn_s_setprio(0); } while (0)
#define PG8_WAIT_V(n) asm volatile("s_waitcnt vmcnt(" #n ")" ::: "memory")
#define PG8_WAIT_L(n) asm volatile("s_waitcnt lgkmcnt(" #n ")" ::: "memory")
#define PG8_BAR __builtin_amdgcn_s_barrier()
#define PG8_SCHED __builtin_amdgcn_sched_barrier(0)
#define PG8_AOFFS(dst0, dst1, ui_, pm_) do { if constexpr (GATHER) { _Pragma("unroll") for (int _i = 0; _i < 2; ++_i) { \
            dst0[_i] = (unsigned)(tab[16 + 256 * (ui_) + sR[_i]] * K + sC[_i]) * 2u; dst1[_i] = (unsigned)(tab[16 + 256 * (ui_) + HALF + sR[_i]] * K + sC[_i]) * 2u; } } \
        else { dst0[0] = voffA[0]; dst0[1] = voffA[1]; dst1[0] = voffA[0]; dst1[1] = voffA[1]; } } while (0)
#define PG8_ABASE(pm_) (GATHER ? (const char*)g.A : (const char*)g.A + (size_t)(pm_) * tstep)
#define PG8_BBASE(ui_, pn_) ((const char*)g.Bt + (use_e ? (size_t)tab[(ui_)] * g.estride * 2 : (size_t)0) + (size_t)(pn_) * tstep)
    Unit cur, nxt; int ui = 0;
    if (!S.next(0, cur)) return;
    f32x4 acc[2][2][4][2];
#pragma unroll
    for (int a = 0; a < 2; ++a)
#pragma unroll
        for (int b = 0; b < 2; ++b)
#pragma unroll
            for (int m = 0; m < 4; ++m)
#pragma unroll
                for (int n = 0; n < 2; ++n) acc[a][b][m][n] = (f32x4){0.f, 0.f, 0.f, 0.f};
    bf16x8 At[4][2], B0[2][2], B1[2][2];
    unsigned ca0[2], ca1[2], na0[2], na1[2];
    PG8_AOFFS(ca0, ca1, 0, cur.pm);
    const char* cA = PG8_ABASE(cur.pm); const char* cB = PG8_BBASE(0, cur.pn);
    PG8_STAGE(PG8_SB(0, 0), cB, voffB); PG8_STAGE(PG8_SB(0, 1), cB + hstep, voffB); PG8_STAGE(PG8_SA(0, 0), cA, ca0); PG8_STAGE(PG8_SA(0, 1), cA + hstepA, ca1);
    if (wr == 1) PG8_BAR;
    PG8_WAIT_V(2); PG8_BAR;
    PG8_STAGE(PG8_SB(1, 0), cB + kstep, voffB); PG8_STAGE(PG8_SA(1, 0), cA + kstep, ca0); PG8_STAGE(PG8_SB(1, 1), cB + hstep + kstep, voffB);
    PG8_WAIT_V(6); PG8_BAR;
    for (;;) {
        const bool has_next = S.next(ui + 1, nxt);
        const char* nA = has_next ? PG8_ABASE(nxt.pm) : cA; const char* nB = has_next ? PG8_BBASE(ui + 1, nxt.pn) : cB;
        if (has_next) { PG8_AOFFS(na0, na1, ui + 1, nxt.pm); } else { na0[0] = ca0[0]; na0[1] = ca0[1]; na1[0] = ca1[0]; na1[1] = ca1[1]; }
        for (int t = 0; t < nt; t += 2) {
            const bool last = (t == nt - 2);
            const char* a1 = cA + (size_t)(t + 1) * kstep;
            const char* a2 = last ? nA : cA + (size_t)(t + 2) * kstep; const char* b2 = last ? nB : cB + (size_t)(t + 2) * kstep;
            const char* a3 = a2 + kstep; const char* b3 = b2 + kstep;
            unsigned x0[2], x1[2];
            x0[0] = last ? na0[0] : ca0[0]; x0[1] = last ? na0[1] : ca0[1]; x1[0] = last ? na1[0] : ca1[0]; x1[1] = last ? na1[1] : ca1[1];
            PG8_LDB(B0, 0, 0); PG8_LDB(B1, 0, 1); PG8_SCHED; PG8_LDA(At, 0, 0); PG8_STAGE(PG8_SA(1, 1), a1 + hstepA, ca1);
            PG8_WAIT_V(8); PG8_WAIT_L(0); PG8_BAR; PG8_MMA(0, 0, At, B0); PG8_MMA(0, 1, At, B1); PG8_BAR; PG8_SCHED;
            PG8_LDA(At, 0, 1); PG8_STAGE(PG8_SB(0, 0), b2, voffB); PG8_STAGE(PG8_SB(0, 1), b2 + hstep, voffB); PG8_STAGE(PG8_SA(0, 0), a2, x0);
            PG8_WAIT_V(8); PG8_WAIT_L(0); PG8_BAR; PG8_MMA(1, 0, At, B0); PG8_MMA(1, 1, At, B1); PG8_BAR; PG8_SCHED;
            PG8_LDB(B0, 1, 0); PG8_LDB(B1, 1, 1); PG8_SCHED; PG8_LDA(At, 1, 0); PG8_STAGE(PG8_SA(0, 1), a2 + hstepA, x1);
            PG8_WAIT_V(8); PG8_WAIT_L(0); PG8_BAR; PG8_MMA(0, 0, At, B0); PG8_MMA(0, 1, At, B1); PG8_BAR; PG8_SCHED;
            PG8_LDA(At, 1, 1); PG8_STAGE(PG8_SB(1, 0), b3, voffB); PG8_STAGE(PG8_SB(1, 1), b3 + hstep, voffB); PG8_STAGE(PG8_SA(1, 0), a3, x0);
            PG8_WAIT_V(8); PG8_WAIT_L(0); PG8_BAR; PG8_MMA(1, 0, At, B0); PG8_MMA(1, 1, At, B1); PG8_BAR; PG8_SCHED;
        }
        if constexpr (ALIGN_EPI) { if (wr == 0) PG8_BAR; }
        if constexpr (!Epi::AFTER_DRAIN) { E(acc, cur, wr, wc, fr, fq); }
        if (!has_next) break;
#pragma unroll
        for (int a = 0; a < 2; ++a)
#pragma unroll
            for (int b = 0; b < 2; ++b)
#pragma unroll
                for (int m = 0; m < 4; ++m)
#pragma unroll
                    for (int n = 0; n < 2; ++n) acc[a][b][m][n] = (f32x4){0.f, 0.f, 0.f, 0.f};
        cur = nxt; cA = nA; cB = nB; ca0[0] = na0[0]; ca0[1] = na0[1]; ca1[0] = na1[0]; ca1[1] = na1[1]; ++ui;
        if constexpr (ALIGN_EPI) { if (wr == 1) PG8_BAR; }
    }
    PG8_WAIT_V(0);
    if constexpr (!ALIGN_EPI) { if (wr == 0) PG8_BAR; }
    PG8_BAR;
    if constexpr (Epi::AFTER_DRAIN) { E.fused(acc, cur, wr, wc, fr, fq, lds, wid, lane); }
#undef PG8_SA
#undef PG8_SB
#undef PG8_STAGE
#undef PG8_LDA
#undef PG8_LDB
#undef PG8_MMA
#undef PG8_WAIT_V
#undef PG8_WAIT_L
#undef PG8_BAR
#undef PG8_SCHED
#undef PG8_AOFFS
#undef PG8_ABASE
#undef PG8_BBASE
}
}

constexpr size_t MiB = 1u << 20;
constexpr size_t WS_CTL = 0, CTL_ZERO_BYTES = 1 * MiB;
constexpr size_t WS_TAB = 1 * MiB, TAB_L = 10 * MiB;
constexpr size_t TB_KMAT = 0, TB_WIN = 1 * MiB, TB_WOUT = 5 * MiB, TB_APT = 9 * MiB, TB_RGWX = 9 * MiB + 65536, TB_RGWA = 9 * MiB + 131072, TB_WGLU = 9 * MiB + 262144;
constexpr size_t WS_WINT = 21 * MiB, WINT_L = (size_t)D_IN * D * 2;
constexpr size_t WS_WOUTT = 30 * MiB, WOUTT_L = (size_t)D * D * 2;
constexpr size_t WS_F13 = 34 * MiB, WS_F2 = 45 * MiB;
constexpr size_t WS_M2 = 51 * MiB, WS_M13 = 95 * MiB;
constexpr size_t E13 = (size_t)2 * FF * D, E2 = (size_t)D * FF;
constexpr size_t WS_OVL = 183 * MiB;
constexpr size_t WS_XN = WS_OVL, WS_QK = 215 * MiB, WS_VT = 247 * MiB, WS_RGS = 263 * MiB, WS_RGH = 287 * MiB, WS_RGA = 303 * MiB, WS_MIX = 319 * MiB, WS_S5Y = 351 * MiB,
                 WS_SLOC = 359 * MiB, WS_RGCP = 361 * MiB, WS_RGCH = 361 * MiB + 262144;
constexpr size_t WS_ACT0 = 215 * MiB, WS_ACT1 = WS_OVL;
constexpr size_t WS_XNM = 1 * MiB, WS_TOKINFO = 36 * MiB, WS_POS = 36 * MiB + 262144, WS_ROWTOK = 36 * MiB + 524288, WS_YEXP = 95 * MiB;
constexpr size_t WS_END = 370 * MiB;
static_assert(WS_ACT1 + (size_t)PMAX * FF * 2 <= WS_END && WS_YEXP + (size_t)PMAX * D * 2 <= WS_OVL && WS_ACT0 + (size_t)M * FF * 2 <= WS_END, "ws map");
static_assert(WS_M13 + NE * E13 * 2 <= WS_OVL && WS_M2 + NE * E2 * 2 <= WS_M13 && WS_F2 + E2 * 2 <= WS_M2 && WS_F13 + E13 * 2 <= WS_F2, "ws map weights");
constexpr int CW_TMO = 0, CW_BAR = 4096, CW_CNT = 8192, CW_ROUTE = 12288, CW_TILEE = 12544;

constexpr int RING_BYTES = 131072, TAB_OFF = RING_BYTES, TAB_BYTES = 12544, MISC_OFF = TAB_OFF + TAB_BYTES, LDS_BYTES = 147456;
static_assert(MISC_OFF + 128 <= LDS_BYTES, "LDS map");
constexpr int NWAVES = 8;

#define XB_TMO      128
#define XB_XCNT(j)  (256  + 64 * (j))
#define XB_XSUB(j)  (1280 + 64 * (j))
#define XB_XGEN(j)  (2304 + 64 * (j))
#define XB_TOP      3328
#define XB_TOPGEN   3392
#define XCD_BAR_WORDS 3456
#define XB_SPIN_CAP (1u << 18)
__device__ __forceinline__ unsigned xb_ld(unsigned* p)              { return __hip_atomic_load(p, __ATOMIC_RELAXED, __HIP_MEMORY_SCOPE_AGENT); }
__device__ __forceinline__ unsigned xb_add(unsigned* p, unsigned v) { return __hip_atomic_fetch_add(p, v, __ATOMIC_RELAXED, __HIP_MEMORY_SCOPE_AGENT); }
__device__ __forceinline__ unsigned xb_xcc_id() { return (unsigned)__builtin_amdgcn_s_getreg((3 << 11) | 20) & 0xFu; }
#define XB_SPIN(cond, bar) do { unsigned _sp = 0; while (cond) { __builtin_amdgcn_s_sleep(1); \
    if ((++_sp & 255u) == 0u) { if (xb_ld(&(bar)[XB_TMO])) break; if (_sp > XB_SPIN_CAP) { atomicAdd(&(bar)[XB_TMO], 1u); break; } } } } while (0)
struct XcdBarrier { unsigned* bar; unsigned x; volatile LAS unsigned* st; };
__device__ __forceinline__ XcdBarrier xcd_barrier_post(unsigned* bar, volatile LAS unsigned* st) {
    XcdBarrier b; b.bar = bar; b.x = xb_xcc_id(); b.st = st;
    if (threadIdx.x == 0) (void)xb_add(&bar[XB_XCNT(b.x)], 1u);
    return b;
}
__device__ __forceinline__ void xcd_barrier_complete(unsigned* bar, unsigned x, unsigned& nloc, unsigned& nx) {
    const unsigned G = gridDim.x * gridDim.y * gridDim.z;
    unsigned sum, cnt, mine, sp = 0u;
    for (;;) {
        sum = 0u; cnt = 0u; mine = 0u;
#pragma unroll
        for (unsigned j = 0; j < 16; ++j) { const unsigned c = xb_ld(&bar[XB_XCNT(j)]); sum += c; cnt += (c > 0u) ? 1u : 0u; mine = (j == x) ? c : mine; }
        if (sum == G) break;
        __builtin_amdgcn_s_sleep(1);
        if ((++sp & 255u) == 0u) { if (xb_ld(&bar[XB_TMO])) break; if (sp > XB_SPIN_CAP) { atomicAdd(&bar[XB_TMO], 1u); break; } }
    }
    nloc = mine > 0u ? mine : 1u; nx = cnt > 0u ? cnt : 1u;
}
__device__ __forceinline__ void xcd_barrier(const XcdBarrier& b) {
    asm volatile("s_waitcnt vmcnt(0)" ::: "memory");
    __syncthreads();
    if (threadIdx.x == 0) {
        unsigned* bar = b.bar;
        __builtin_amdgcn_s_waitcnt(0);
        unsigned nloc = b.st[0], nx = b.st[1];
        if (nloc == 0u) { xcd_barrier_complete(bar, b.x, nloc, nx); b.st[0] = nloc; b.st[1] = nx; }
        const unsigned old = xb_add(&bar[XB_XSUB(b.x)], 1u);
        const unsigned gen = old / nloc;
        if (old + 1u == (gen + 1u) * nloc) {
            __builtin_amdgcn_fence(__ATOMIC_RELEASE, "agent");
            asm volatile("s_waitcnt vmcnt(0)" ::: "memory");
            const unsigned og = xb_add(&bar[XB_TOP], 1u);
            const unsigned tg = og / nx;
            if (og + 1u == (tg + 1u) * nx) xb_add(&bar[XB_TOPGEN], 1u);
            else XB_SPIN(xb_ld(&bar[XB_TOPGEN]) == tg, bar);
            __builtin_amdgcn_fence(__ATOMIC_ACQUIRE, "agent");
            xb_add(&bar[XB_XGEN(b.x)], 1u);
            asm volatile("s_waitcnt vmcnt(0)" ::: "memory");
        } else {
            XB_SPIN(xb_ld(&bar[XB_XGEN(b.x)]) == gen, bar);
            __builtin_amdgcn_fence(__ATOMIC_ACQUIRE, "agent");
            asm volatile("s_waitcnt vmcnt(0)" ::: "memory");
        }
    }
    __syncthreads();
}

struct Inputs {
    const float *x, *norm_mix_g, *w_in, *rel_bias, *rg_conv_w, *rg_conv_b, *rg_wx, *rg_bx, *rg_wa, *rg_ba, *rg_lambda,
                *s5_a_re, *s5_a_im, *s5_log_dt, *s5_b_re, *s5_b_im, *s5_c_re, *s5_c_im, *s5_d, *s5_w_glu, *g_group, *w_out, *norm_ffn_g,
                *ffn_w1, *ffn_w3, *ffn_w2, *moe_router, *moe_w1, *moe_w3, *moe_w2, *final_norm_g;
};
struct Args { Inputs in; float* out; unsigned char* ws; int ph_lo, ph_hi; };
struct Frame {
    LAS unsigned char* lds;
    unsigned char* ws;
    gu32* ctl;
    int tid, lane, wave, G, wg;
    const __attribute__((address_space(4))) struct Args* ka;
    float* out;
};
template <class T> __device__ __forceinline__ T* wsp(const Frame& F, size_t off) { return (T*)(F.ws + off); }

__device__ __forceinline__ void p0_transpose_item(const float* W, int K, int N, bf16_t* WT, int row_off, int mode, LAS float* scr, int item, int lane) {
    const int nblk = N / 32, kb = item / nblk, nb = item % nblk, k0 = 64 * kb, n0 = 32 * nb;
#pragma unroll 8
    for (int i = 0; i < 32; ++i) { const int kk = 2 * i + (lane >> 5); scr[kk * 33 + (lane & 31)] = W[(size_t)(k0 + kk) * N + n0 + (lane & 31)]; }
    LDS_WAIT(); asm volatile("" ::: "memory");
    const int c = lane & 7;
    const int drow0 = (mode == 0) ? (row_off + n0) : (256 * (n0 >> 7) + (n0 & 127) + (mode == 2 ? 128 : 0));
#pragma unroll
    for (int j = 0; j < 4; ++j) { const int n = (lane >> 3) + 8 * j; const LAS float* s = scr + (8 * c) * 33 + n;
        u32x4 o; o.x = pk2(s[0 * 33], s[1 * 33]); o.y = pk2(s[2 * 33], s[3 * 33]); o.z = pk2(s[4 * 33], s[5 * 33]); o.w = pk2(s[6 * 33], s[7 * 33]);
        *(GAS u32x4*)(WT + (size_t)(drow0 + n) * K + k0 + 8 * c) = o; }
    LDS_WAIT(); asm volatile("" ::: "memory");
}
__device__ __forceinline__ void rms_row_to_bf16(int lane, const float* xrow, const float* g, bf16_t* orow) {
    const GAS f32x4* xr = (const GAS f32x4*)xrow + lane; const GAS f32x4* gr = (const GAS f32x4*)g + lane;
    f32x4 v[4]; float s = 0.f;
#pragma unroll
    for (int j = 0; j < 4; ++j) { v[j] = xr[64 * j]; s += (v[j].x * v[j].x + v[j].y * v[j].y) + (v[j].z * v[j].z + v[j].w * v[j].w); }
    const float rstd = 1.f / sqrtf(wave_sum(s) * (1.f / D) + EPS);
    GAS unsigned long long* o8 = (GAS unsigned long long*)orow + lane;
#pragma unroll
    for (int j = 0; j < 4; ++j) { const f32x4 gg = gr[64 * j]; o8[64 * j] = (unsigned long long)pk2(v[j].x * rstd * gg.x, v[j].y * rstd * gg.y) | ((unsigned long long)pk2(v[j].z * rstd * gg.z, v[j].w * rstd * gg.w) << 32); }
}
__device__ __forceinline__ void norm_phase(Frame& F, const float* src, const float* g, bf16_t* dst) {
    const int gw = F.wg * NWAVES + F.wave, NGW = F.G * NWAVES;
    for (int m = gw; m < M; m += NGW) rms_row_to_bf16(F.lane, src + (size_t)m * D, g, dst + (size_t)m * D);
}
__device__ __forceinline__ void s5_pow(float are, float aim, float dt, int k, float& pr, float& pi) {
    const float mag = expf(are * dt * (float)k);
    double ph = (double)aim * (double)dt * (double)k; ph -= 6.283185307179586476925 * rint(ph * 0.15915494309189533577);
    float s, c; sincosf((float)ph, &s, &c); pr = mag * c; pi = mag * s;
}
__device__ __forceinline__ void s5_q(float are, float aim, float dt, float& qr, float& qi) {
    const float zr = are * dt, zi = aim * dt;
    float s, c; sincosf(zi, &s, &c); const float sh = sinf(0.5f * zi);
    const float em1 = expm1f(zr), e = em1 + 1.0f;
    const float nr = em1 * c - 2.0f * sh * sh, ni = e * s;
    const float den = are * are + aim * aim;
    qr = (nr * are + ni * aim) / den; qi = (ni * are - nr * aim) / den;
}
__device__ __forceinline__ void p0_tables(Frame& F, int l) {
    const int gt = F.wg * 512 + F.tid, NT = F.G * 512;
    const float* are_ = F.ka->in.s5_a_re + l * S5G * S5P; const float* aim_ = F.ka->in.s5_a_im + l * S5G * S5P; const float* ldt_ = F.ka->in.s5_log_dt + l * S5G;
    const float* bre_ = F.ka->in.s5_b_re + (size_t)l * S5G * S5P * S5C; const float* bim_ = F.ka->in.s5_b_im + (size_t)l * S5G * S5P * S5C;
    const float* cre_ = F.ka->in.s5_c_re + (size_t)l * S5G * S5C * S5P; const float* cim_ = F.ka->in.s5_c_im + (size_t)l * S5G * S5C * S5P;
    unsigned char* tb = F.ws + WS_TAB + l * TAB_L;
    bf16_t* KMAT = (bf16_t*)(tb + TB_KMAT); bf16_t* WIN = (bf16_t*)(tb + TB_WIN); bf16_t* WOUT = (bf16_t*)(tb + TB_WOUT); float* APT = (float*)(tb + TB_APT);
    for (int it = gt; it < S5G * S5P * CHUNK; it += NT) {
        const int s = it & 63, p = (it >> 6) & 63, g = it >> 12;
        const float are = are_[g * S5P + p], aim = aim_[g * S5P + p], dt = expf(ldt_[g]);
        float pr, pi, qr, qi; s5_pow(are, aim, dt, CHUNK - 1 - s, pr, pi); s5_q(are, aim, dt, qr, qi);
        const float wr_ = pr * qr - pi * qi, wi_ = pr * qi + pi * qr;
        bf16_t* o_re = WIN + ((size_t)(g * 128 + p) * 1024 + s * 16); bf16_t* o_im = WIN + ((size_t)(g * 128 + 64 + p) * 1024 + s * 16);
#pragma unroll
        for (int ci = 0; ci < 16; ++ci) { const float br = bre_[(g * S5P + p) * S5C + ci], bi = bim_[(g * S5P + p) * S5C + ci];
            o_re[ci] = (bf16_t)f2bf(wr_ * br - wi_ * bi); o_im[ci] = (bf16_t)f2bf(wr_ * bi + wi_ * br); }
        if (s == 0) { float ar, ai; s5_pow(are, aim, dt, CHUNK, ar, ai); APT[(g * S5P + p) * 2] = ar; APT[(g * S5P + p) * 2 + 1] = ai; }
    }
    for (int it = gt; it < S5G * CHUNK * S5C * 4; it += NT) {
        const int pq = it & 3, co = (it >> 2) & 15, t = (it >> 6) & 63, g = it >> 12;
        const float dt = expf(ldt_[g]);
        bf16_t* o = WOUT + (size_t)(g * 1024 + t * 16 + co) * 128;
        for (int p = pq * 16; p < pq * 16 + 16; ++p) { float pr, pi; s5_pow(are_[g * S5P + p], aim_[g * S5P + p], dt, t + 1, pr, pi);
            const float cr = cre_[(g * S5C + co) * S5P + p], ci = cim_[(g * S5C + co) * S5P + p];
            o[p] = (bf16_t)f2bf(cr * pr - ci * pi); o[64 + p] = (bf16_t)f2bf(-(cr * pi + ci * pr)); }
    }
    for (int it = gt; it < S5G * 65 * S5C; it += NT) {
        const int co = it & 15, li = (it >> 4) % 65, g = (it >> 4) / 65;
        float a[16];
#pragma unroll
        for (int ci = 0; ci < 16; ++ci) a[ci] = 0.f;
        if (li > 0) { const float dt = expf(ldt_[g]);
            for (int p = 0; p < S5P; ++p) { const float are = are_[g * S5P + p], aim = aim_[g * S5P + p];
                float pr, pi, qr, qi; s5_pow(are, aim, dt, li - 1, pr, pi); s5_q(are, aim, dt, qr, qi);
                const float cr = cre_[(g * S5C + co) * S5P + p], cim = cim_[(g * S5C + co) * S5P + p];
                const float t1r = cr * pr - cim * pi, t1i = cr * pi + cim * pr;
                const float t2r = t1r * qr - t1i * qi, t2i = t1r * qi + t1i * qr;
#pragma unroll
                for (int ci = 0; ci < 16; ++ci) a[ci] += t2r * bre_[(g * S5P + p) * S5C + ci] - t2i * bim_[(g * S5P + p) * S5C + ci]; } }
        bf16_t* o = KMAT + (size_t)((g * 65 + li) * 16 + co) * 16;
#pragma unroll
        for (int ci = 0; ci < 16; ++ci) o[ci] = (bf16_t)f2bf(a[ci]);
    }
    bf16_t* WXT = (bf16_t*)(tb + TB_RGWX); bf16_t* WAT = (bf16_t*)(tb + TB_RGWA);
    const float* wx = F.ka->in.rg_wx + (size_t)l * 4 * 64 * 64; const float* wa = F.ka->in.rg_wa + (size_t)l * 4 * 64 * 64;
    for (int it = gt; it < 4 * 64 * 64; it += NT) { const int i = it & 63, o = (it >> 6) & 63, hb = it >> 12;
        WXT[it] = (bf16_t)f2bf(wx[(hb * 64 + i) * 64 + o]); WAT[it] = (bf16_t)f2bf(wa[(hb * 64 + i) * 64 + o]); }
}
__device__ __forceinline__ void p0_prologue(Frame& F) {
    LAS float* scr = (LAS float*)(F.lds + F.wave * 16384);
    const int gw = F.wg * NWAVES + F.wave, NGW = F.G * NWAVES;
    constexpr int I_IN = (D / 64) * (D_IN / 32), I_OUT = (D / 64) * (D / 32), I_UP = (D / 64) * (FF / 32), I_DN = (FF / 64) * (D / 32), I_GLU = (256 / 64) * (256 / 32);
    constexpr int NITEMS = 2 * I_IN + 2 * I_OUT + 2 * I_GLU + (1 + NE) * (2 * I_UP + I_DN);
    for (int it = gw; it < NITEMS; it += NGW) {
        int r = it;
        if (r < 2 * I_IN) { const int l = r / I_IN; p0_transpose_item(F.ka->in.w_in + (size_t)l * D * D_IN, D, D_IN, wsp<bf16_t>(F, WS_WINT + l * WINT_L), 0, 0, scr, r % I_IN, F.lane); continue; } r -= 2 * I_IN;
        if (r < 2 * I_OUT) { const int l = r / I_OUT; p0_transpose_item(F.ka->in.w_out + (size_t)l * D * D, D, D, wsp<bf16_t>(F, WS_WOUTT + l * WOUTT_L), 0, 0, scr, r % I_OUT, F.lane); continue; } r -= 2 * I_OUT;
        if (r < 2 * I_GLU) { const int l = r / I_GLU; p0_transpose_item(F.ka->in.s5_w_glu + (size_t)l * 256 * 256, 256, 256, wsp<bf16_t>(F, WS_TAB + l * TAB_L + TB_WGLU), 0, 0, scr, r % I_GLU, F.lane); continue; } r -= 2 * I_GLU;
        const int e = r / (2 * I_UP + I_DN); r -= e * (2 * I_UP + I_DN);
        const float* w1 = e ? F.ka->in.moe_w1 + (size_t)(e - 1) * D * FF : F.ka->in.ffn_w1; const float* w3 = e ? F.ka->in.moe_w3 + (size_t)(e - 1) * D * FF : F.ka->in.ffn_w3;
        const float* w2 = e ? F.ka->in.moe_w2 + (size_t)(e - 1) * FF * D : F.ka->in.ffn_w2;
        bf16_t* d13 = e ? wsp<bf16_t>(F, WS_M13) + (size_t)(e - 1) * E13 : wsp<bf16_t>(F, WS_F13); bf16_t* d2 = e ? wsp<bf16_t>(F, WS_M2) + (size_t)(e - 1) * E2 : wsp<bf16_t>(F, WS_F2);
        if (r < I_UP) { p0_transpose_item(w1, D, FF, d13, 0, 1, scr, r, F.lane); continue; } r -= I_UP;
        if (r < I_UP) { p0_transpose_item(w3, D, FF, d13, 0, 2, scr, r, F.lane); continue; } r -= I_UP;
        p0_transpose_item(w2, FF, D, d2, 0, 0, scr, r, F.lane);
    }
    p0_tables(F, 0); p0_tables(F, 1);
    norm_phase(F, F.ka->in.x, F.ka->in.norm_mix_g, wsp<bf16_t>(F, WS_XN));
}

__device__ __forceinline__ bf16x8 pack8(const f32x16& v, int base) {
    u32x4 w; w.x = pg8::cvt_pk_bf16(v[base + 0], v[base + 1]); w.y = pg8::cvt_pk_bf16(v[base + 2], v[base + 3]); w.z = pg8::cvt_pk_bf16(v[base + 4], v[base + 5]); w.w = pg8::cvt_pk_bf16(v[base + 6], v[base + 7]);
    return __builtin_bit_cast(bf16x8, w);
}
__device__ __forceinline__ void attn_unit(Frame& F, int layer, int b, int c) {
    const int h = F.wave, lane = F.lane, l31 = lane & 31, hi = lane >> 5;
    LAS float* btab = (LAS float*)F.lds;
    LAS float* red = (LAS float*)(F.lds + 8448);
    const float* rb = F.ka->in.rel_bias + (size_t)layer * NHEAD * 257;
    for (int i = F.tid; i < NHEAD * 257; i += 512) { const int hh = i / 257, j = i - hh * 257; btab[hh * 260 + j] = rb[i] * LOG2E; }
    LDS_WAIT(); __syncthreads();
    const bf16_t* QK = wsp<bf16_t>(F, WS_QK); const bf16_t* VT = wsp<bf16_t>(F, WS_VT); bf16_t* MIX = wsp<bf16_t>(F, WS_MIX);
    const size_t tok0 = (size_t)b * SEQ + c * CHUNK;
    const int kslot = 32 * ((l31 >> 2) & 1) + 4 * (l31 >> 3) + (l31 & 3);
    const LAS float* bt = btab + h * 260;
    f32x16 o[2][2];
    for (int qt = 0; qt < 2; ++qt) {
        bf16x8 qf[4];
#pragma unroll
        for (int ks = 0; ks < 4; ++ks) qf[ks] = *(const bf16x8*)(QK + (tok0 + 32 * qt + l31) * 1024 + h * HD + 32 * hi + 8 * ks);
        f32x16 o0, o1;
#pragma unroll
        for (int r = 0; r < 16; ++r) { o0[r] = 0.f; o1[r] = 0.f; }
        float mrun = -1e30f, lrun = 0.f;
        for (int cb = (c >= 8 ? 0 : 8 - c); cb <= 8; ++cb) {
            const int kc = c - 8 + cb;
            const size_t kt0 = (size_t)b * SEQ + kc * CHUNK;
            bf16x8 kf[2][4], vf[2][2][2];
#pragma unroll
            for (int t2 = 0; t2 < 2; ++t2)
#pragma unroll
                for (int ks = 0; ks < 4; ++ks) kf[t2][ks] = *(const bf16x8*)(QK + (kt0 + kslot + 16 * t2) * 1024 + 512 + h * HD + 32 * hi + 8 * ks);
#pragma unroll
            for (int dt = 0; dt < 2; ++dt)
#pragma unroll
                for (int t2 = 0; t2 < 2; ++t2)
#pragma unroll
                    for (int s = 0; s < 2; ++s) vf[dt][t2][s] = *(const bf16x8*)(VT + ((size_t)b * D_ATTN + h * HD + 32 * dt + l31) * SEQ + kc * CHUNK + 32 * hi + 16 * t2 + 8 * s);
            f32x16 s0, s1;
#pragma unroll
            for (int r = 0; r < 16; ++r) { s0[r] = 0.f; s1[r] = 0.f; }
#pragma unroll
            for (int ks = 0; ks < 4; ++ks) { s0 = __builtin_amdgcn_mfma_f32_32x32x16_bf16(kf[0][ks], qf[ks], s0, 0, 0, 0); s1 = __builtin_amdgcn_mfma_f32_32x32x16_bf16(kf[1][ks], qf[ks], s1, 0, 0, 0); }
            const int rb0 = (8 - cb) * CHUNK + 32 * qt + l31 - 32 * hi;
            float mx = -1e30f;
#pragma unroll
            for (int r = 0; r < 16; ++r) { int i0 = rb0 - r; i0 = (i0 > 128 ? 128 : i0) + 128; int i1 = rb0 - 16 - r; i1 = (i1 > 128 ? 128 : i1) + 128;
                s0[r] += bt[i0]; s1[r] += bt[i1]; mx = fmaxf(mx, fmaxf(s0[r], s1[r])); }
            mx = fmaxf(mx, __shfl_xor(mx, 32));
            const float mnew = fmaxf(mrun, mx), alpha = fexp2(mrun - mnew); mrun = mnew;
            float ps = 0.f;
#pragma unroll
            for (int r = 0; r < 16; ++r) { s0[r] = fexp2(s0[r] - mnew); s1[r] = fexp2(s1[r] - mnew); ps += s0[r] + s1[r]; }
            lrun = lrun * alpha + ps;
#pragma unroll
            for (int r = 0; r < 16; ++r) { o0[r] *= alpha; o1[r] *= alpha; }
            const bf16x8 p00 = pack8(s0, 0), p01 = pack8(s0, 8), p10 = pack8(s1, 0), p11 = pack8(s1, 8);
            o0 = __builtin_amdgcn_mfma_f32_32x32x16_bf16(vf[0][0][0], p00, o0, 0, 0, 0); o0 = __builtin_amdgcn_mfma_f32_32x32x16_bf16(vf[0][0][1], p01, o0, 0, 0, 0);
            o0 = __builtin_amdgcn_mfma_f32_32x32x16_bf16(vf[0][1][0], p10, o0, 0, 0, 0); o0 = __builtin_amdgcn_mfma_f32_32x32x16_bf16(vf[0][1][1], p11, o0, 0, 0, 0);
            o1 = __builtin_amdgcn_mfma_f32_32x32x16_bf16(vf[1][0][0], p00, o1, 0, 0, 0); o1 = __builtin_amdgcn_mfma_f32_32x32x16_bf16(vf[1][0][1], p01, o1, 0, 0, 0);
            o1 = __builtin_amdgcn_mfma_f32_32x32x16_bf16(vf[1][1][0], p10, o1, 0, 0, 0); o1 = __builtin_amdgcn_mfma_f32_32x32x16_bf16(vf[1][1][1], p11, o1, 0, 0, 0);
        }
        const float lt = lrun + __shfl_xor(lrun, 32), inv = 1.0f / lt; float ss = 0.f;
#pragma unroll
        for (int r = 0; r < 16; ++r) { o0[r] *= inv; o1[r] *= inv; ss += o0[r] * o0[r] + o1[r] * o1[r]; }
        ss += __shfl_xor(ss, 32);
        if (hi == 0) red[h * 64 + 32 * qt + l31] = ss;
        if (qt == 0) { o[0][0] = o0; o[0][1] = o1; } else { o[1][0] = o0; o[1][1] = o1; }
    }
    LDS_WAIT(); __syncthreads();
    const float* gg = F.ka->in.g_group + (size_t)layer * D + h * HD;
#pragma unroll
    for (int qt = 0; qt < 2; ++qt) {
        float tot = 0.f;
#pragma unroll
        for (int hh = 0; hh < NHEAD; ++hh) tot += red[hh * 64 + 32 * qt + l31];
        const float rstd = 1.0f / sqrtf(tot * (1.0f / D_ATTN) + EPS);
        bf16_t* orow = MIX + (tok0 + 32 * qt + l31) * 1024 + h * HD;
#pragma unroll
        for (int dt = 0; dt < 2; ++dt)
#pragma unroll
            for (int g4 = 0; g4 < 4; ++g4) { const int d0 = 32 * dt + 8 * g4 + 4 * hi; const f32x4 gv = *(const f32x4*)(gg + d0);
                u32x2 w; w.x = pg8::cvt_pk_bf16(o[qt][dt][4 * g4 + 0] * rstd * gv[0], o[qt][dt][4 * g4 + 1] * rstd * gv[1]); w.y = pg8::cvt_pk_bf16(o[qt][dt][4 * g4 + 2] * rstd * gv[2], o[qt][dt][4 * g4 + 3] * rstd * gv[3]);
                *(u32x2*)(orow + d0) = w; }
    }
    __syncthreads();
}

constexpr int XCB_PITCH = 264;
__device__ __forceinline__ void rg1_unit(Frame& F, int layer, int b, int c) {
    const int tid = F.tid, lane = F.lane, l31 = lane & 31, hi = lane >> 5, w = F.wave;
    LAS float* XC = (LAS float*)F.lds;
    LAS bf16_t* XCB = (LAS bf16_t*)(F.lds + 65536);
    const bf16_t* RGS = wsp<bf16_t>(F, WS_RGS);
    const size_t tok0 = (size_t)b * SEQ + c * CHUNK;
    { const int ch = tid & 255, th = tid >> 8; const int tl0 = c * CHUNK + 32 * th;
        const float* cw = F.ka->in.rg_conv_w + (size_t)layer * 4 * D_RG; const float w0 = cw[ch], w1 = cw[D_RG + ch], w2 = cw[2 * D_RG + ch], w3 = cw[3 * D_RG + ch], cbv = F.ka->in.rg_conv_b[layer * D_RG + ch];
        const bf16_t* xp = RGS + ((size_t)b * SEQ + tl0) * 768 + ch;
        float xm3 = tl0 >= 3 ? bf2f(xp[-3 * 768]) : 0.f, xm2 = tl0 >= 2 ? bf2f(xp[-2 * 768]) : 0.f, xm1 = tl0 >= 1 ? bf2f(xp[-1 * 768]) : 0.f;
#pragma unroll 8
        for (int i = 0; i < 32; ++i) { const float x0 = bf2f(xp[(size_t)i * 768]); const float xc = w0 * xm3 + w1 * xm2 + w2 * xm1 + w3 * x0 + cbv;
            XC[(32 * th + i) * 256 + ch] = xc; XCB[(32 * th + i) * XCB_PITCH + ch] = (bf16_t)f2bf(xc); xm3 = xm2; xm2 = xm1; xm1 = x0; } }
    LDS_WAIT(); __syncthreads();
    const int hb = w >> 1, nt = w & 1, chn = hb * 64 + nt * 32 + l31;
    const unsigned char* tb = F.ws + WS_TAB + layer * TAB_L;
    const bf16_t* WXT = (const bf16_t*)(tb + TB_RGWX) + (size_t)(hb * 64 + nt * 32 + l31) * 64; const bf16_t* WAT = (const bf16_t*)(tb + TB_RGWA) + (size_t)(hb * 64 + nt * 32 + l31) * 64;
    const int trow = 16 * ((l31 >> 2) & 1) + 4 * (l31 >> 3) + (l31 & 3);
    f32x16 gxa[2], gaa[2];
#pragma unroll
    for (int tt = 0; tt < 2; ++tt)
#pragma unroll
        for (int r = 0; r < 16; ++r) { gxa[tt][r] = 0.f; gaa[tt][r] = 0.f; }
#pragma unroll
    for (int ks = 0; ks < 4; ++ks) { const bf16x8 bx = *(const bf16x8*)(WXT + 16 * ks + 8 * hi), ba = *(const bf16x8*)(WAT + 16 * ks + 8 * hi);
#pragma unroll
        for (int tt = 0; tt < 2; ++tt) { const bf16x8 a = *(const LAS bf16x8*)(XCB + (32 * tt + trow) * XCB_PITCH + hb * 64 + 16 * ks + 8 * hi);
            gxa[tt] = __builtin_amdgcn_mfma_f32_32x32x16_bf16(a, bx, gxa[tt], 0, 0, 0); gaa[tt] = __builtin_amdgcn_mfma_f32_32x32x16_bf16(a, ba, gaa[tt], 0, 0, 0); } }
    const float bxv = F.ka->in.rg_bx[layer * D_RG + chn], bav = F.ka->in.rg_ba[layer * D_RG + chn], lam = F.ka->in.rg_lambda[layer * D_RG + chn];
    const float c8 = -8.0f * log1pf(expf(-lam));
#pragma unroll
    for (int tt = 0; tt < 2; ++tt) { float P = 1.f, H = 0.f;
#pragma unroll
        for (int r = 0; r < 16; ++r) { const float xv = XC[(32 * tt + 16 * hi + r) * 256 + chn];
            const float gx = sigmoidf_(gxa[tt][r] + bxv), ga = sigmoidf_(gaa[tt][r] + bav);
            const float la = c8 * ga, a = expf(la), mult = sqrtf(-expm1f(2.0f * la));
            H = a * H + mult * gx * xv; P = a * P; gxa[tt][r] = H; gaa[tt][r] = P; } }
    float oP[2], oH[2];
#pragma unroll
    for (int tt = 0; tt < 2; ++tt) { oP[tt] = __shfl_xor(gaa[tt][15], 32); oH[tt] = __shfl_xor(gxa[tt][15], 32); }
    const float P0 = hi ? oP[0] : gaa[0][15], H0 = hi ? oH[0] : gxa[0][15], P1 = hi ? gaa[0][15] : oP[0], H1 = hi ? gxa[0][15] : oH[0];
    const float P2 = hi ? oP[1] : gaa[1][15], H2 = hi ? oH[1] : gxa[1][15], P3 = hi ? gaa[1][15] : oP[1], H3 = hi ? gxa[1][15] : oH[1];
    const float Pc2 = P0 * P1, Hc2 = P1 * H0 + H1, Pc3 = Pc2 * P2, Hc3 = P2 * Hc2 + H2, Pt = Pc3 * P3, Ht = P3 * Hc3 + H3;
    float Pc[2], Hc[2]; Pc[0] = hi ? P0 : 1.f; Hc[0] = hi ? H0 : 0.f; Pc[1] = hi ? Pc3 : Pc2; Hc[1] = hi ? Hc3 : Hc2;
    float* RGH = wsp<float>(F, WS_RGH); float* RGA = wsp<float>(F, WS_RGA);
#pragma unroll
    for (int tt = 0; tt < 2; ++tt)
#pragma unroll
        for (int r = 0; r < 16; ++r) { const size_t o = (tok0 + 32 * tt + 16 * hi + r) * 256 + chn; RGA[o] = Pc[tt] * gaa[tt][r]; RGH[o] = gaa[tt][r] * Hc[tt] + gxa[tt][r]; }
    if (hi == 0) { wsp<float>(F, WS_RGCP)[(size_t)(b * NCH + c) * 256 + chn] = Pt; wsp<float>(F, WS_RGCH)[(size_t)(b * NCH + c) * 256 + chn] = Ht; }
    __syncthreads();
}
__device__ __forceinline__ void rg3_unit(Frame& F, int layer, int b, int c) {
    const int tid = F.tid, ch = tid & 255, th = tid >> 8;
    LAS float* red = (LAS float*)F.lds;
    const float* CP = wsp<float>(F, WS_RGCP) + (size_t)b * NCH * 256 + ch; const float* CH = wsp<float>(F, WS_RGCH) + (size_t)b * NCH * 256 + ch;
    float Hs = 0.f;
    for (int j = 0; j < c; ++j) Hs = CP[j * 256] * Hs + CH[j * 256];
    const size_t tok0 = (size_t)b * SEQ + c * CHUNK + 32 * th;
    const float* RGH = wsp<float>(F, WS_RGH) + tok0 * 256 + ch; const float* RGA = wsp<float>(F, WS_RGA) + tok0 * 256 + ch; const bf16_t* GATE = wsp<bf16_t>(F, WS_RGS) + tok0 * 768 + 256 + ch;
    float y[32];
#pragma unroll
    for (int i = 0; i < 32; ++i) { const float hv = RGH[i * 256] + RGA[i * 256] * Hs; y[i] = hv * gelu_tanh(bf2f(GATE[(size_t)i * 768])); }
#pragma unroll
    for (int i = 0; i < 32; ++i) { const float s = wave_sum(y[i] * y[i]); if (F.lane == 0) red[(32 * th + i) * 4 + (F.wave & 3)] = s; }
    LDS_WAIT(); __syncthreads();
    const float gv = F.ka->in.g_group[(size_t)layer * D + 512 + ch];
    bf16_t* MIX = wsp<bf16_t>(F, WS_MIX) + tok0 * 1024 + 512 + ch;
#pragma unroll
    for (int i = 0; i < 32; ++i) { const f32x4 p = *(const LAS f32x4*)(red + (32 * th + i) * 4); const float rstd = 1.0f / sqrtf(((p[0] + p[1]) + (p[2] + p[3])) * (1.0f / D_RG) + EPS);
        MIX[(size_t)i * 1024] = (bf16_t)f2bf(y[i] * rstd * gv); }
    __syncthreads();
}

__device__ __forceinline__ void s5loc_unit(Frame& F, int layer, int g, int mt) {
    const int lane = F.lane, l31 = lane & 31, hi = lane >> 5, w = F.wave, ntile = w & 3, sh = w >> 2;
    LAS float* xch = (LAS float*)F.lds;
    const unsigned char* tb = F.ws + WS_TAB + layer * TAB_L;
    const bf16_t* WIN = (const bf16_t*)(tb + TB_WIN) + (size_t)(g * 128 + 32 * ntile + l31) * 1024 + 8 * hi;
    const int u = 32 * mt + l31;
    const bf16_t* US = wsp<bf16_t>(F, WS_RGS) + ((size_t)(u >> 6) * SEQ + (u & 63) * CHUNK) * 768 + 512 + g * 16 + 8 * hi;
    f32x16 acc;
#pragma unroll
    for (int r = 0; r < 16; ++r) acc[r] = 0.f;
#pragma unroll 8
    for (int s = 32 * sh; s < 32 * sh + 32; ++s) { const bf16x8 a = *(const bf16x8*)(US + (size_t)s * 768), bb = *(const bf16x8*)(WIN + s * 16);
        acc = __builtin_amdgcn_mfma_f32_32x32x16_bf16(a, bb, acc, 0, 0, 0); }
    if (sh == 1) {
#pragma unroll
        for (int r = 0; r < 16; ++r) xch[(ntile * 64 + lane) * 16 + r] = acc[r]; }
    LDS_WAIT(); __syncthreads();
    if (sh == 0) { float* SL = wsp<float>(F, WS_SLOC);
#pragma unroll
        for (int r = 0; r < 16; ++r) { const int row = (r & 3) + 8 * (r >> 2) + 4 * hi; SL[((size_t)(32 * mt + row) * S5G + g) * 128 + 32 * ntile + l31] = acc[r] + xch[(ntile * 64 + lane) * 16 + r]; } }
    __syncthreads();
}
constexpr int HS_PITCH = 136;
__device__ __forceinline__ void s5y_unit(Frame& F, int layer, int g, int mt) {
    const int lane = F.lane, l31 = lane & 31, hi = lane >> 5, w = F.wave;
    LAS bf16_t* HS = (LAS bf16_t*)F.lds;
    const unsigned char* tb = F.ws + WS_TAB + layer * TAB_L;
    const int b = mt >> 1, c0 = 32 * (mt & 1);
    if (w == 0) { const float* APT = (const float*)(tb + TB_APT) + (g * S5P + lane) * 2; const float ar = APT[0], ai = APT[1];
        const float* SL = wsp<float>(F, WS_SLOC) + ((size_t)(b * NCH) * S5G + g) * 128 + lane;
        float hr = 0.f, hm = 0.f;
        for (int cc = 0; cc < c0 + 32; ++cc) {
            if (cc >= c0) { HS[(cc - c0) * HS_PITCH + lane] = (bf16_t)f2bf(hr); HS[(cc - c0) * HS_PITCH + 64 + lane] = (bf16_t)f2bf(hm); }
            const float sr = SL[(size_t)cc * S5G * 128], si = SL[(size_t)cc * S5G * 128 + 64];
            const float nr = ar * hr - ai * hm + sr, ni = ar * hm + ai * hr + si; hr = nr; hm = ni; } }
    LDS_WAIT(); __syncthreads();
    const bf16_t* KMAT = (const bf16_t*)(tb + TB_KMAT) + (size_t)g * 65 * 256 + (l31 & 15) * 16 + 8 * hi;
    const bf16_t* WOUT = (const bf16_t*)(tb + TB_WOUT) + (size_t)g * 1024 * 128 + 8 * hi;
    const bf16_t* US = wsp<bf16_t>(F, WS_RGS) + ((size_t)b * SEQ + (c0 + l31) * CHUNK) * 768 + 512 + g * 16 + 8 * hi;
    const int tl = l31 >> 4;
    int jn[4]; jn[0] = w; jn[1] = 15 - w; jn[2] = 16 + w; jn[3] = 31 - w;
    f32x16 acc[4];
#pragma unroll
    for (int q = 0; q < 4; ++q)
#pragma unroll
        for (int r = 0; r < 16; ++r) acc[q][r] = 0.f;
    for (int s = 0; s < CHUNK; ++s) { const bf16x8 a = *(const bf16x8*)(US + (size_t)s * 768);
#pragma unroll
        for (int q = 0; q < 4; ++q) if (s <= 2 * jn[q] + 1) { const int li = 2 * jn[q] + tl - s + 1; const bf16x8 bb = *(const bf16x8*)(KMAT + (size_t)li * 256);
            acc[q] = __builtin_amdgcn_mfma_f32_32x32x16_bf16(a, bb, acc[q], 0, 0, 0); } }
#pragma unroll
    for (int ks = 0; ks < 8; ++ks) { const bf16x8 a = *(const LAS bf16x8*)(HS + l31 * HS_PITCH + 16 * ks + 8 * hi);
#pragma unroll
        for (int q = 0; q < 4; ++q) { const bf16x8 bb = *(const bf16x8*)(WOUT + (size_t)(32 * jn[q] + l31) * 128 + 16 * ks);
            acc[q] = __builtin_amdgcn_mfma_f32_32x32x16_bf16(a, bb, acc[q], 0, 0, 0); } }
    const int ch = g * 16 + (l31 & 15); const float dv = F.ka->in.s5_d[layer * D_S5 + ch];
    const bf16_t* RGS = wsp<bf16_t>(F, WS_RGS); bf16_t* S5Y = wsp<bf16_t>(F, WS_S5Y);
#pragma unroll
    for (int q = 0; q < 4; ++q)
#pragma unroll
        for (int r = 0; r < 16; ++r) { const int row = (r & 3) + 8 * (r >> 2) + 4 * hi; const size_t tok = (size_t)b * SEQ + (c0 + row) * CHUNK + 2 * jn[q] + tl;
            const float uv = bf2f(RGS[tok * 768 + 512 + ch]); S5Y[tok * 256 + ch] = (bf16_t)f2bf(gelu_tanh(acc[q][r] + dv * uv)); }
    __syncthreads();
}

__device__ __forceinline__ void r1_phase(Frame& F) {
    LAS float* rt = (LAS float*)F.lds;
    LAS int* cnt = (LAS int*)(F.lds + 32768);
    for (int i = F.tid; i < NE * D; i += 512) { const int e = i >> 10, k = i & 1023; rt[i] = F.ka->in.moe_router[k * NE + e]; }
    if (F.tid < NE) cnt[F.tid] = 0;
    LDS_WAIT(); __syncthreads();
    const int TPW = M / F.G, per_wave = TPW / NWAVES;
    const float* XS = F.out; bf16_t* XNM = wsp<bf16_t>(F, WS_XNM); unsigned* TI = wsp<unsigned>(F, WS_TOKINFO);
    const GAS f32x4* gr = (const GAS f32x4*)(F.ka->in.norm_ffn_g + D) + F.lane;
    for (int ti = 0; ti < per_wave; ++ti) {
        const int tok = F.wg * TPW + F.wave * per_wave + ti;
        const GAS f32x4* xr = (const GAS f32x4*)(XS + (size_t)tok * D) + F.lane;
        f32x4 v[4]; float s = 0.f;
#pragma unroll
        for (int j = 0; j < 4; ++j) { v[j] = xr[64 * j]; s += (v[j].x * v[j].x + v[j].y * v[j].y) + (v[j].z * v[j].z + v[j].w * v[j].w); }
        const float rstd = 1.f / sqrtf(wave_sum(s) * (1.f / D) + EPS);
        GAS unsigned long long* o8 = (GAS unsigned long long*)(XNM + (size_t)tok * D) + F.lane;
#pragma unroll
        for (int j = 0; j < 4; ++j) { const f32x4 gg = gr[64 * j]; v[j].x *= rstd * gg.x; v[j].y *= rstd * gg.y; v[j].z *= rstd * gg.z; v[j].w *= rstd * gg.w;
            o8[64 * j] = (unsigned long long)pk2(v[j].x, v[j].y) | ((unsigned long long)pk2(v[j].z, v[j].w) << 32); }
        float lg[NE];
#pragma unroll
        for (int e = 0; e < NE; ++e) { float a = 0.f;
#pragma unroll
            for (int j = 0; j < 4; ++j) { const f32x4 r = *(const LAS f32x4*)(rt + e * D + 256 * j + 4 * F.lane); a += (v[j].x * r.x + v[j].y * r.y) + (v[j].z * r.z + v[j].w * r.w); }
            lg[e] = wave_sum(a); }
        int i1 = 0; float l1 = lg[0];
#pragma unroll
        for (int e = 1; e < NE; ++e) if (lg[e] > l1) { l1 = lg[e]; i1 = e; }
        int i2 = -1; float l2 = -3.0e38f;
#pragma unroll
        for (int e = 0; e < NE; ++e) if (e != i1 && lg[e] > l2) { l2 = lg[e]; i2 = e; }
        const float g1 = 1.0f / (1.0f + expf(l2 - l1)), g2 = 1.0f - g1;
        if (F.lane == 0) { *(u32x4*)(TI + (size_t)tok * 4) = (u32x4){(unsigned)i1, (unsigned)i2, __float_as_uint(g1), __float_as_uint(g2)}; __hip_atomic_fetch_add(&cnt[i1], 1, __ATOMIC_RELAXED, __HIP_MEMORY_SCOPE_WORKGROUP); __hip_atomic_fetch_add(&cnt[i2], 1, __ATOMIC_RELAXED, __HIP_MEMORY_SCOPE_WORKGROUP); }
    }
    LDS_WAIT(); __syncthreads();
    if (F.tid < NE) __hip_atomic_store((unsigned*)F.ctl + CW_CNT + F.wg * NE + F.tid, (unsigned)cnt[F.tid], RLX_AGENT);
    __syncthreads();
}
__device__ __forceinline__ void r2_phase(Frame& F) {
    LAS int* sh = (LAS int*)F.lds;
    if (F.tid < NE) { int tot = 0, mine = 0;
        for (int w = 0; w < F.G; ++w) { const int c = (int)__hip_atomic_load((unsigned*)F.ctl + CW_CNT + w * NE + F.tid, RLX_AGENT); tot += c; if (w < F.wg) mine += c; }
        sh[F.tid] = tot; sh[8 + F.tid] = mine; }
    LDS_WAIT(); __syncthreads();
    if (F.tid == 0) { int ps = 0; for (int e = 0; e < NE; ++e) { sh[16 + e] = ps; sh[24 + e] = ps + sh[8 + e]; ps += (sh[e] + 255) & ~255; } sh[160] = ps; }
    LDS_WAIT(); __syncthreads();
    const int TPW = M / F.G, NA = 2 * TPW;
    const unsigned* TI = wsp<unsigned>(F, WS_TOKINFO); int* POS = wsp<int>(F, WS_POS); int* ROWTOK = wsp<int>(F, WS_ROWTOK);
    int e_mine = 0;
    if (F.tid < NA) { e_mine = (int)TI[(size_t)(F.wg * TPW + (F.tid >> 1)) * 4 + (F.tid & 1)]; sh[32 + F.tid] = e_mine; }
    LDS_WAIT(); __syncthreads();
    if (F.tid < NA) { int rank = 0; for (int t = 0; t < F.tid; ++t) rank += (sh[32 + t] == e_mine) ? 1 : 0;
        const int pos = sh[24 + e_mine] + rank; const int tok = F.wg * TPW + (F.tid >> 1);
        POS[tok * 2 + (F.tid & 1)] = pos; ROWTOK[pos] = tok; }
    if (F.wg == 0) {
        for (int e = 0; e < NE; ++e) { const int ps = sh[16 + e], tot = sh[e], pc = (tot + 255) & ~255;
            for (int p = ps + tot + F.tid; p < ps + pc; p += 512) ROWTOK[p] = 0;
            for (int t = ps / 256 + F.tid; t < (ps + pc) / 256; t += 512) __hip_atomic_store((unsigned*)F.ctl + CW_TILEE + t, (unsigned)e, RLX_AGENT); }
        if (F.tid == 0) __hip_atomic_store((unsigned*)F.ctl + CW_ROUTE + 16, (unsigned)(sh[160] / 256), RLX_AGENT);
    }
    __syncthreads();
}
__device__ __forceinline__ void combine_phase(Frame& F) {
    const int gw = F.wg * NWAVES + F.wave, NGW = F.G * NWAVES;
    const unsigned* TI = wsp<unsigned>(F, WS_TOKINFO); const int* POS = wsp<int>(F, WS_POS); const bf16_t* Y = wsp<bf16_t>(F, WS_YEXP);
    const GAS f32x4* gr = (const GAS f32x4*)F.ka->in.final_norm_g + F.lane;
    for (int tok = gw; tok < M; tok += NGW) {
        const u32x4 ti = *(const u32x4*)(TI + (size_t)tok * 4); const float g1 = __uint_as_float(ti.z), g2 = __uint_as_float(ti.w);
        const int p1 = POS[tok * 2], p2 = POS[tok * 2 + 1];
        GAS f32x4* xr = (GAS f32x4*)(F.out + (size_t)tok * D) + F.lane;
        const GAS u32x2* y1 = (const GAS u32x2*)(Y + (size_t)p1 * D) + F.lane; const GAS u32x2* y2 = (const GAS u32x2*)(Y + (size_t)p2 * D) + F.lane;
        f32x4 v[4]; float s = 0.f;
#pragma unroll
        for (int j = 0; j < 4; ++j) { v[j] = xr[64 * j]; const u32x2 a = y1[64 * j], b = y2[64 * j];
            v[j].x += g1 * bflo(a.x) + g2 * bflo(b.x); v[j].y += g1 * bfhi(a.x) + g2 * bfhi(b.x); v[j].z += g1 * bflo(a.y) + g2 * bflo(b.y); v[j].w += g1 * bfhi(a.y) + g2 * bfhi(b.y);
            s += (v[j].x * v[j].x + v[j].y * v[j].y) + (v[j].z * v[j].z + v[j].w * v[j].w); }
        const float rstd = 1.f / sqrtf(wave_sum(s) * (1.f / D) + EPS);
#pragma unroll
        for (int j = 0; j < 4; ++j) { const f32x4 gg = gr[64 * j]; xr[64 * j] = (f32x4){v[j].x * rstd * gg.x, v[j].y * rstd * gg.y, v[j].z * rstd * gg.z, v[j].w * rstd * gg.w}; }
    }
}

constexpr int NPHASE = 20;
typedef const __attribute__((address_space(4))) Args* KArgs;
#define NEWFRAME(F) Frame F; { KArgs ka_ = (KArgs)__builtin_amdgcn_kernarg_segment_ptr(); asm volatile("" : "+s"(ka_)); int t_ = threadIdx.x; asm volatile("" : "+v"(t_)); \
    F.ka = ka_; F.lds = (LAS unsigned char*)lds_raw; F.ws = ka_->ws; F.ctl = (gu32*)(ka_->ws + WS_CTL); F.out = ka_->out; \
    F.tid = t_; F.lane = t_ & 63; F.wave = __builtin_amdgcn_readfirstlane(t_ >> 6); F.G = gridDim.x; F.wg = blockIdx.x; }
__global__ void __launch_bounds__(NWAVES * 64, 2) fwd(Args args) {
    extern __shared__ __attribute__((aligned(16))) unsigned char lds_raw[];
    volatile LAS unsigned* MISC = (volatile LAS unsigned*)((LAS unsigned char*)lds_raw + MISC_OFF);
    if (threadIdx.x < 32) MISC[threadIdx.x] = 0u;
    __syncthreads();
    const int lo = args.ph_lo, hi = args.ph_hi;
    if (hi - lo > 1) { (void)xcd_barrier_post((unsigned*)(args.ws + WS_CTL) + CW_BAR, MISC + 8); }
#ifndef PHASE_MASK
#define PHASE_MASK 0xFFFFFu
#endif
#define IN(k) ((((PHASE_MASK) >> (k)) & 1u) && lo <= (k) && (k) < hi)
#define SEAM(k) do { if (IN(k) && IN((k) + 1)) { KArgs kb_ = (KArgs)__builtin_amdgcn_kernarg_segment_ptr(); asm volatile("" : "+s"(kb_)); \
        XcdBarrier bar_; bar_.bar = (unsigned*)(kb_->ws + WS_CTL) + CW_BAR; bar_.x = xb_xcc_id(); bar_.st = (volatile LAS unsigned*)((LAS unsigned char*)lds_raw + MISC_OFF) + 8; xcd_barrier(bar_); } } while (0)
#define TABP ((LAS int*)(F.lds + TAB_OFF))

    if (IN(0)) { NEWFRAME(F); p0_prologue(F); } SEAM(0);
#pragma unroll 1
    for (int l = 0; l < DEPTH; ++l) {
        const int pb = 1 + 9 * l;
        if (IN(pb)) {
            NEWFRAME(F);
            pg8::Gemm g{wsp<bf16_t>(F, WS_XN), wsp<bf16_t>(F, WS_WINT + l * WINT_L), D_IN, D, nullptr, nullptr, 0};
            pg8::StaticOrder S; S.init(M / 256, D_IN, F.G, F.wg);
            pg8::EpiProj E{wsp<bf16_t>(F, WS_QK), wsp<bf16_t>(F, WS_VT), wsp<bf16_t>(F, WS_RGS)};
            pg8::gemm_phase<pg8::EpiProj, true, false>(F.lds, TABP, g, S, E);
        } SEAM(pb);
        if (IN(pb + 1)) {
            NEWFRAME(F);
#ifndef MIXA_MASK
#define MIXA_MASK 7
#endif
            if (MIXA_MASK & 1) for (int u = F.wg; u < NUNIT; u += F.G) attn_unit(F, l, u >> 6, u & 63);
            if (MIXA_MASK & 2) for (int u = F.wg; u < NUNIT; u += F.G) rg1_unit(F, l, u >> 6, u & 63);
            if (MIXA_MASK & 4) for (int u = F.wg; u < S5G * 8; u += F.G) s5loc_unit(F, l, u >> 3, u & 7);
        } SEAM(pb + 1);
        if (IN(pb + 2)) {
            NEWFRAME(F);
            for (int u = F.wg; u < S5G * 8; u += F.G) s5y_unit(F, l, u >> 3, u & 7);
            for (int u = F.G - 1 - F.wg; u < NUNIT; u += F.G) rg3_unit(F, l, u >> 6, u & 63);
        } SEAM(pb + 2);
        if (IN(pb + 3)) {
            NEWFRAME(F);
            pg8::Gemm g{wsp<bf16_t>(F, WS_S5Y), wsp<bf16_t>(F, WS_TAB + l * TAB_L + TB_WGLU), 256, 256, nullptr, nullptr, 0};
            pg8::StaticOrder S; S.init(M / 256, 256, F.G, F.wg);
            pg8::EpiGLU E{wsp<bf16_t>(F, WS_S5Y), wsp<bf16_t>(F, WS_MIX) + 768, F.ka->in.g_group + (size_t)l * D + 768};
            pg8::gemm_phase<pg8::EpiGLU, false, false>(F.lds, TABP, g, S, E);
        } SEAM(pb + 3);
        if (IN(pb + 4)) {
            NEWFRAME(F);
            pg8::Gemm g{wsp<bf16_t>(F, WS_MIX), wsp<bf16_t>(F, WS_WOUTT + l * WOUTT_L), D, D, nullptr, nullptr, 0};
            pg8::StaticOrder S; S.init(M / 256, D, F.G, F.wg);
            pg8::EpiResid E{l == 0 ? F.ka->in.x : F.out, F.out, D};
            pg8::gemm_phase<pg8::EpiResid, true, false>(F.lds, TABP, g, S, E);
        } SEAM(pb + 4);
        if (l == 0) {
            if (IN(6)) { NEWFRAME(F); norm_phase(F, F.out, F.ka->in.norm_ffn_g, wsp<bf16_t>(F, WS_XN)); } SEAM(6);
            if (IN(7)) {
                NEWFRAME(F);
                pg8::Gemm g{wsp<bf16_t>(F, WS_XN), wsp<bf16_t>(F, WS_F13), 2 * FF, D, nullptr, nullptr, 0};
                pg8::StaticOrder S; S.init(M / 256, 2 * FF, F.G, F.wg);
                pg8::EpiSwiGLU E{wsp<bf16_t>(F, WS_ACT0), FF};
                pg8::gemm_phase<pg8::EpiSwiGLU, true, false>(F.lds, TABP, g, S, E);
            } SEAM(7);
            if (IN(8)) {
                NEWFRAME(F);
                pg8::Gemm g{wsp<bf16_t>(F, WS_ACT0), wsp<bf16_t>(F, WS_F2), D, FF, nullptr, nullptr, 0};
                pg8::StaticOrder S; S.init(M / 256, D, F.G, F.wg);
                pg8::EpiResid E{F.out, F.out, D};
                pg8::gemm_phase<pg8::EpiResid, true, false>(F.lds, TABP, g, S, E);
            } SEAM(8);
            if (IN(9)) { NEWFRAME(F); norm_phase(F, F.out, F.ka->in.norm_mix_g + D, wsp<bf16_t>(F, WS_XN)); } SEAM(9);
        } else {
            if (IN(15)) { NEWFRAME(F); r1_phase(F); } SEAM(15);
            if (IN(16)) { NEWFRAME(F); r2_phase(F); } SEAM(16);
            if (IN(17)) {
                NEWFRAME(F);
                const int ntile = (int)__hip_atomic_load((unsigned*)F.ctl + CW_ROUTE + 16, RLX_AGENT);
                pg8::Gemm g{wsp<bf16_t>(F, WS_XNM), wsp<bf16_t>(F, WS_M13), 2 * FF, D, wsp<int>(F, WS_ROWTOK), (const int*)(F.ctl + CW_TILEE), E13};
                pg8::StaticOrder S; S.init(ntile, 2 * FF, F.G, F.wg);
                pg8::EpiSwiGLU E{wsp<bf16_t>(F, WS_ACT1), FF};
                pg8::gemm_phase<pg8::EpiSwiGLU, true, true>(F.lds, TABP, g, S, E);
            } SEAM(17);
            if (IN(18)) {
                NEWFRAME(F);
                const int ntile = (int)__hip_atomic_load((unsigned*)F.ctl + CW_ROUTE + 16, RLX_AGENT);
                pg8::Gemm g{wsp<bf16_t>(F, WS_ACT1), wsp<bf16_t>(F, WS_M2), D, FF, nullptr, (const int*)(F.ctl + CW_TILEE), E2};
                pg8::StaticOrder S; S.init(ntile, D, F.G, F.wg);
                pg8::EpiBf16 E{wsp<bf16_t>(F, WS_YEXP), D};
                pg8::gemm_phase<pg8::EpiBf16, true, false>(F.lds, TABP, g, S, E);
            } SEAM(18);
            if (IN(19)) { NEWFRAME(F); combine_phase(F); }
        }
    }
#undef IN
#undef SEAM
}

extern "C" void kernel_launch(void* const* d_in, const int* in_sizes, int n_in, void* d_out, int out_size, void* d_ws, size_t ws_size, hipStream_t stream) {
    static int grid = 0;
    if (grid == 0) {
        if (n_in != 31 || in_sizes[0] != M * D || out_size != M * D || ws_size < WS_END) { fprintf(stderr, "kernel_launch: unexpected problem: n_in %d in0 %d out %d ws %zu (need %zu)\n", n_in, n_in > 0 ? in_sizes[0] : -1, out_size, ws_size, (size_t)WS_END); grid = -1; return; }
        int dev = 0, cus = 0, per_cu = 0;
        if (hipGetDevice(&dev) != hipSuccess || hipDeviceGetAttribute(&cus, hipDeviceAttributeMultiprocessorCount, dev) != hipSuccess) { grid = -1; return; }
        if (hipFuncSetAttribute((const void*)fwd, hipFuncAttributeMaxDynamicSharedMemorySize, LDS_BYTES) != hipSuccess) { fprintf(stderr, "kernel_launch: hipFuncSetAttribute failed\n"); grid = -1; return; }
        if (hipOccupancyMaxActiveBlocksPerMultiprocessor(&per_cu, (const void*)fwd, NWAVES * 64, LDS_BYTES) != hipSuccess || per_cu < 1) { fprintf(stderr, "kernel_launch: occupancy query says %d blocks per CU\n", per_cu); grid = -1; (void)hipGetLastError(); return; }
        grid = cus;
        if (grid != 256) { fprintf(stderr, "kernel_launch: built for 256 CUs, found %d\n", cus); grid = -1; return; }
    }
    if (grid < 0) return;
    (void)hipMemsetAsync((char*)d_ws + WS_CTL, 0, CTL_ZERO_BYTES, stream);
    Args a{};
    const float** ip = (const float**)&a.in;
    for (int i = 0; i < 31; ++i) ip[i] = (const float*)d_in[i];
    a.out = (float*)d_out; a.ws = (unsigned char*)d_ws;
#if MK_N_LAUNCHES == 1
    a.ph_lo = 0; a.ph_hi = NPHASE;
    hipLaunchKernelGGL(fwd, dim3(grid), dim3(NWAVES * 64), LDS_BYTES, stream, a);
#else
    for (int p = 0; p < NPHASE; ++p) { a.ph_lo = p; a.ph_hi = p + 1; hipLaunchKernelGGL(fwd, dim3(grid), dim3(NWAVES * 64), LDS_BYTES, stream, a); }
#endif
}
```

```cpp
#include <hip/hip_runtime.h>
#include <cstdio>
#include <cstdint>
#include <cmath>

#ifndef MK_N_LAUNCHES
#define MK_N_LAUNCHES 1
#endif

constexpr int BATCH = 4, SEQ = 4096, D = 1024, M = BATCH * SEQ;
constexpr int DEPTH = 2;
constexpr int CHUNK = 64, NCH = SEQ / CHUNK, NUNIT = BATCH * NCH;
constexpr int D_ATTN = 512, D_RG = 256, D_S5 = 256, D_IN = 2304;
constexpr int NHEAD = 8, HD = 64;
constexpr int FF = 2816, NE = 8;
constexpr int S5G = 16, S5C = 16, S5P = 64;
constexpr float EPS = 1e-6f;
constexpr float LOG2E = 1.4426950408889634f;
constexpr float QSCALE = 0.125f * LOG2E;
constexpr int PMAX = 2 * M + NE * 256;
constexpr int PTILES = PMAX / 256;

#define GAS __attribute__((address_space(1)))
#define LAS __attribute__((address_space(3)))
typedef unsigned short bf16_t;
typedef short bf16x8 __attribute__((ext_vector_type(8)));
typedef float f32x4 __attribute__((ext_vector_type(4)));
typedef float f32x2 __attribute__((ext_vector_type(2)));
typedef float f32x16 __attribute__((ext_vector_type(16)));
typedef unsigned u32x4 __attribute__((ext_vector_type(4)));
typedef unsigned u32x2 __attribute__((ext_vector_type(2)));
typedef GAS unsigned gu32;
#define RLX_AGENT __ATOMIC_RELAXED, __HIP_MEMORY_SCOPE_AGENT
#define LDS_WAIT() asm volatile("s_waitcnt lgkmcnt(0)" ::: "memory")
#define VM_WAIT() asm volatile("s_waitcnt vmcnt(0)" ::: "memory")

__device__ __forceinline__ unsigned f2bf(float f) { unsigned u = __builtin_bit_cast(unsigned, f); return (u + 0x7fffu + ((u >> 16) & 1u)) >> 16; }
__device__ __forceinline__ unsigned pk2(float lo, float hi) { return f2bf(lo) | (f2bf(hi) << 16); }
__device__ __forceinline__ float bf2f(unsigned short h) { return __builtin_bit_cast(float, (unsigned)h << 16); }
__device__ __forceinline__ float bflo(unsigned w) { return __builtin_bit_cast(float, w << 16); }
__device__ __forceinline__ float bfhi(unsigned w) { return __builtin_bit_cast(float, w & 0xffff0000u); }
__device__ __forceinline__ float fexp2(float x) { return __builtin_amdgcn_exp2f(x); }
__device__ __forceinline__ float frcp(float x) { return __builtin_amdgcn_rcpf(x); }
__device__ __forceinline__ float sigmoidf_(float x) { return frcp(1.0f + fexp2(-x * LOG2E)); }
__device__ __forceinline__ float gelu_tanh(float x) {
    const float z = 0.7978845608028654f * (x + 0.044715f * x * x * x);
    return x * frcp(1.0f + fexp2(-2.0f * LOG2E * z));
}
__device__ __forceinline__ int hw_lane() { unsigned m = ~0u; asm volatile("" : "+s"(m)); return (int)__builtin_amdgcn_mbcnt_hi(m, __builtin_amdgcn_mbcnt_lo(m, 0u)); }
__device__ __forceinline__ float shx(float v, int mask) { return __builtin_bit_cast(float, __builtin_amdgcn_ds_bpermute((hw_lane() ^ mask) << 2, __builtin_bit_cast(int, v))); }
__device__ __forceinline__ float wave_sum(float v) {
#pragma unroll
    for (int o = 1; o < 64; o <<= 1) v += shx(v, o);
    return v;
}

namespace pg8 {
#define PG8_LAS __attribute__((address_space(3)))
constexpr int BM = 256, BK = 64, HALF = 128, HTB = HALF * BK * 2  , STAGE_BYTES = 8 * HTB, NXCD = 8, WGM = 8;
constexpr int MAXU = 12;

__host__ __device__ __forceinline__ int lds_byte(int r, int c) { const int st = (r >> 4) * 2 + (c >> 5), rr = r & 15, cc = c & 31, ob = rr * 64 + cc * 2; return st * 1024 + (ob ^ (((ob >> 9) & 1) << 5)); }
__host__ __device__ __forceinline__ void stage_rc(int b, int& R, int& C) { const int st = b / 1024, sb = b % 1024, swz = sb ^ (((sb >> 9) & 1) << 5); R = (st >> 1) * 16 + swz / 64; C = (st & 1) * 32 + (swz % 64) / 2; }
__host__ __device__ __forceinline__ int perm32(int rho) { const int n = rho >> 4, i = rho & 15; return 8 * (i >> 2) + 4 * n + (i & 3); }

struct Unit { int pm, pn, ui; };
struct Gemm { const bf16_t* A; const bf16_t* Bt; int N, K; const int* rowtok; const int* tile_e; size_t estride; const unsigned char* ws; const float* ssq; };

struct StaticOrder {
    int nM, nN, nwg, G, c;
    __host__ __device__ void init(int nM_, int N, int G_, int c_) { nM = nM_; nN = N / BM; nwg = nM * nN; G = G_; c = c_; }
    __host__ __device__ __forceinline__ bool next(int i, Unit& u) const {
        const long L = (long)i * G + c; if (L >= nwg) return false;
        int wgid = (int)L; { const int q = nwg / NXCD, r = nwg % NXCD, xcd = wgid % NXCD, off = wgid / NXCD; wgid = (xcd < r ? xcd * (q + 1) : r * (q + 1) + (xcd - r) * q) + off; }
        const int nig = WGM * nN, gid = wgid / nig, fm = gid * WGM, gsz = (nM - fm) < WGM ? (nM - fm) : WGM;
        u.pm = fm + ((wgid % nig) % gsz); u.pn = (wgid % nig) / gsz; return true;
    }
};

__device__ __forceinline__ unsigned cvt_pk_bf16(float lo, float hi) { unsigned r; asm volatile("v_cvt_pk_bf16_f32 %0, %1, %2" : "=v"(r) : "v"(lo), "v"(hi)); return r; }


struct EpiProj {
    static constexpr bool PERM = true, AFTER_DRAIN = false;
    bf16_t* Q; bf16_t* KC; bf16_t* VC; bf16_t* RGS; const PG8_LAS float* rs;
    __device__ __forceinline__ void operator()(const f32x4 (&acc)[2][2][4][2], const Unit& u, int wr, int wc, int fr, int fq) const {
        const int row0 = u.pm * BM + wr * 64 + fr;
        float rsv[2][4];
#pragma unroll
        for (int ai = 0; ai < 2; ++ai)
#pragma unroll
            for (int m = 0; m < 4; ++m) rsv[ai][m] = rs[256 * u.ui + wr * 64 + fr + ai * HALF + m * 16];
        if (u.pn < 2 || u.pn >= 6) {
            bf16_t* base; int ldc, colt; float sc = 1.f;
            if (u.pn < 2) { base = Q; ldc = 512; colt = u.pn * BM; sc = QSCALE; } else { base = RGS; ldc = 768; colt = (u.pn - 6) * BM; }
            const int col0 = colt + wc * 32 + 8 * fq;
#pragma unroll
            for (int ai = 0; ai < 2; ++ai)
#pragma unroll
                for (int m = 0; m < 4; ++m) { bf16_t* rowp = base + (size_t)(row0 + ai * HALF + m * 16) * ldc + col0;
#pragma unroll
                    for (int bj = 0; bj < 2; ++bj) { const float sr = sc * rsv[ai][m]; const f32x4 v0 = acc[ai][bj][m][0] * sr, v1 = acc[ai][bj][m][1] * sr;
                        u32x4 w; w.x = cvt_pk_bf16(v0[0], v0[1]); w.y = cvt_pk_bf16(v0[2], v0[3]); w.z = cvt_pk_bf16(v1[0], v1[1]); w.w = cvt_pk_bf16(v1[2], v1[3]);
                        *(u32x4*)(rowp + bj * HALF) = w; } }
        } else if (u.pn < 4) {
            const int ck0 = (u.pn - 2) * BM + wc * 32 + 8 * fq;
#pragma unroll
            for (int ai = 0; ai < 2; ++ai)
#pragma unroll
                for (int m = 0; m < 4; ++m) { const int r = row0 + ai * HALF + m * 16;
#pragma unroll
                    for (int bj = 0; bj < 2; ++bj) { const int ck = ck0 + bj * HALF; const f32x4 v0 = acc[ai][bj][m][0] * rsv[ai][m], v1 = acc[ai][bj][m][1] * rsv[ai][m];
                        u32x4 w; w.x = cvt_pk_bf16(v0[0], v0[1]); w.y = cvt_pk_bf16(v0[2], v0[3]); w.z = cvt_pk_bf16(v1[0], v1[1]); w.w = cvt_pk_bf16(v1[2], v1[3]);
                        *(u32x4*)(KC + ((size_t)((r >> 6) * NHEAD + (ck >> 6)) * 64 + (r & 63)) * 64 + (ck & 63)) = w; } }
        } else {
            const int cv0 = (u.pn - 4) * BM + wc * 32 + 8 * fq;
#pragma unroll
            for (int ai = 0; ai < 2; ++ai)
#pragma unroll
                for (int m = 0; m < 4; ++m) { const int r = row0 + ai * HALF + m * 16;
#pragma unroll
                    for (int bj = 0; bj < 2; ++bj) { const int cv = cv0 + bj * HALF; bf16_t* vp = VC + ((size_t)((r >> 6) * NHEAD + (cv >> 6)) * 64 + (cv & 63)) * 64 + (r & 63);
#pragma unroll
                        for (int n = 0; n < 2; ++n)
#pragma unroll
                            for (int j = 0; j < 4; ++j) vp[(4 * n + j) * 64] = (bf16_t)f2bf(acc[ai][bj][m][n][j] * rsv[ai][m]); } }
        }
    }
};
struct EpiResid {
    static constexpr bool PERM = true, AFTER_DRAIN = false, INIT = true;
    const float* base32; const bf16_t* base16; bf16_t* out; float* ssq;
    __device__ __forceinline__ void init(f32x4 (&acc)[2][2][4][2], const Unit& u, int wr, int wc, int fr, int fq) const {
        const int row0 = u.pm * BM + wr * 64 + fr, col0 = u.pn * BM + wc * 32 + 8 * fq;
#pragma unroll
        for (int ai = 0; ai < 2; ++ai)
#pragma unroll
            for (int m = 0; m < 4; ++m) { const size_t off = (size_t)(row0 + ai * HALF + m * 16) * D + col0;
#pragma unroll
                for (int bj = 0; bj < 2; ++bj) {
                    if (base32) { acc[ai][bj][m][0] = *(const f32x4*)(base32 + off + bj * HALF); acc[ai][bj][m][1] = *(const f32x4*)(base32 + off + bj * HALF + 4); }
                    else { const u32x4 w = *(const u32x4*)(base16 + off + bj * HALF);
                        acc[ai][bj][m][0] = (f32x4){bflo(w.x), bfhi(w.x), bflo(w.y), bfhi(w.y)}; acc[ai][bj][m][1] = (f32x4){bflo(w.z), bfhi(w.z), bflo(w.w), bfhi(w.w)}; } } }
    }
    __device__ __forceinline__ void operator()(const f32x4 (&acc)[2][2][4][2], const Unit& u, int wr, int wc, int fr, int fq) const {
        const int row0 = u.pm * BM + wr * 64 + fr, col0 = u.pn * BM + wc * 32 + 8 * fq;
#pragma unroll
        for (int ai = 0; ai < 2; ++ai)
#pragma unroll
            for (int m = 0; m < 4; ++m) { const size_t off = (size_t)(row0 + ai * HALF + m * 16) * D + col0; float ss = 0.f;
#pragma unroll
                for (int bj = 0; bj < 2; ++bj) { const f32x4 v0 = acc[ai][bj][m][0], v1 = acc[ai][bj][m][1];
                    ss += ((v0[0] * v0[0] + v0[1] * v0[1]) + (v0[2] * v0[2] + v0[3] * v0[3])) + ((v1[0] * v1[0] + v1[1] * v1[1]) + (v1[2] * v1[2] + v1[3] * v1[3]));
                    u32x4 w; w.x = cvt_pk_bf16(v0[0], v0[1]); w.y = cvt_pk_bf16(v0[2], v0[3]); w.z = cvt_pk_bf16(v1[0], v1[1]); w.w = cvt_pk_bf16(v1[2], v1[3]);
                    *(u32x4*)(out + off + bj * HALF) = w; }
                ss += shx(ss, 16); ss += shx(ss, 32);
                if (fq == 0) ssq[(size_t)(row0 + ai * HALF + m * 16) * 16 + 4 * u.pn + wc] = ss; }
    }
};
struct EpiSwiGLU {
    static constexpr bool PERM = true, AFTER_DRAIN = false;
    bf16_t* O; int ldc; const PG8_LAS float* rs;
    __device__ __forceinline__ void operator()(const f32x4 (&acc)[2][2][4][2], const Unit& u, int wr, int wc, int fr, int fq) const {
        const int row0 = u.pm * BM + wr * 64 + fr, col0 = u.pn * HALF + wc * 32 + 8 * fq;
#pragma unroll
        for (int ai = 0; ai < 2; ++ai)
#pragma unroll
            for (int m = 0; m < 4; ++m) { bf16_t* rowp = O + (size_t)(row0 + ai * HALF + m * 16) * ldc + col0;
                const float r_ = rs[256 * u.ui + wr * 64 + fr + ai * HALF + m * 16];
                float v[8];
#pragma unroll
                for (int n = 0; n < 2; ++n)
#pragma unroll
                    for (int j = 0; j < 4; ++j) { const float a = acc[ai][0][m][n][j] * r_, b = acc[ai][1][m][n][j] * r_; v[4 * n + j] = a * sigmoidf_(a) * b; }
                u32x4 w; w.x = cvt_pk_bf16(v[0], v[1]); w.y = cvt_pk_bf16(v[2], v[3]); w.z = cvt_pk_bf16(v[4], v[5]); w.w = cvt_pk_bf16(v[6], v[7]);
                *(u32x4*)rowp = w; }
    }
};
__device__ __forceinline__ unsigned pk4_fp8(float a, float b, float c, float d) { int r = 0; r = __builtin_amdgcn_cvt_pk_fp8_f32(a, b, r, false); r = __builtin_amdgcn_cvt_pk_fp8_f32(c, d, r, true); return (unsigned)r; }
struct EpiSwiGLU8 {
    static constexpr bool PERM = true, AFTER_DRAIN = false;
    unsigned char* O; static constexpr int ldc = FF;
    __device__ __forceinline__ void operator()(const f32x4 (&acc)[2][2][4][2], const Unit& u, int wr, int wc, int fr_, int fq_) const {
        int fr = fr_, fq = fq_; asm volatile("" : "+v"(fr), "+v"(fq));
        const int row0 = u.pm * BM + wr * 64 + fr, col0 = u.pn * HALF + wc * 32 + 8 * fq;
#pragma unroll
        for (int ai = 0; ai < 2; ++ai)
#pragma unroll
            for (int m = 0; m < 4; ++m) { unsigned char* rowp = O + (size_t)(row0 + ai * HALF + m * 16) * ldc + col0;
                float v[8];
#pragma unroll
                for (int n = 0; n < 2; ++n)
#pragma unroll
                    for (int j = 0; j < 4; ++j) { const float a = acc[ai][0][m][n][j], b = acc[ai][1][m][n][j]; v[4 * n + j] = a * sigmoidf_(a) * b; }
                *(u32x2*)rowp = (u32x2){pk4_fp8(v[0], v[1], v[2], v[3]), pk4_fp8(v[4], v[5], v[6], v[7])}; }
    }
};
struct EpiBf16 {
    static constexpr bool PERM = true, AFTER_DRAIN = false;
    bf16_t* O; int ldc;
    __device__ __forceinline__ void operator()(const f32x4 (&acc)[2][2][4][2], const Unit& u, int wr, int wc, int fr, int fq) const {
        const int row0 = u.pm * BM + wr * 64 + fr, col0 = u.pn * BM + wc * 32 + 8 * fq;
#pragma unroll
        for (int ai = 0; ai < 2; ++ai)
#pragma unroll
            for (int m = 0; m < 4; ++m) { bf16_t* rowp = O + (size_t)(row0 + ai * HALF + m * 16) * ldc + col0;
#pragma unroll
                for (int bj = 0; bj < 2; ++bj) { const f32x4 v0 = acc[ai][bj][m][0], v1 = acc[ai][bj][m][1];
                    u32x4 w; w.x = cvt_pk_bf16(v0[0], v0[1]); w.y = cvt_pk_bf16(v0[2], v0[3]); w.z = cvt_pk_bf16(v1[0], v1[1]); w.w = cvt_pk_bf16(v1[2], v1[3]);
                    *(u32x4*)(rowp + bj * HALF) = w; } }
    }
};
struct EpiGLU {
    static constexpr bool PERM = true, AFTER_DRAIN = true;
    const bf16_t* Y; bf16_t* MIXO; const float* gg;
    __device__ __forceinline__ void fused(f32x4 (&acc)[2][2][4][2], const Unit& u, int wr, int wc, int fr, int fq, PG8_LAS unsigned char* lds, int wid, int lane) const {
        PG8_LAS float* P = (PG8_LAS float*)lds;
        const int row0 = u.pm * BM + wr * 64 + fr, col0 = wc * 32 + 8 * fq;
#pragma unroll
        for (int ai = 0; ai < 2; ++ai)
#pragma unroll
            for (int m = 0; m < 4; ++m) { const bf16_t* yp = Y + (size_t)(row0 + ai * HALF + m * 16) * 256 + col0; float ss = 0.f;
#pragma unroll
                for (int bj = 0; bj < 2; ++bj) { const u32x4 yw = *(const u32x4*)(yp + bj * HALF);
                    const float yv[8] = {bflo(yw.x), bfhi(yw.x), bflo(yw.y), bfhi(yw.y), bflo(yw.z), bfhi(yw.z), bflo(yw.w), bfhi(yw.w)};
#pragma unroll
                    for (int n = 0; n < 2; ++n)
#pragma unroll
                        for (int j = 0; j < 4; ++j) { const float o = yv[4 * n + j] * sigmoidf_(acc[ai][bj][m][n][j]); acc[ai][bj][m][n][j] = o; ss += o * o; } }
                ss += shx(ss, 16); ss += shx(ss, 32);
                if (fq == 0) P[(ai * HALF + wr * 64 + m * 16 + fr) * 4 + wc] = ss; }
        asm volatile("s_waitcnt lgkmcnt(0)" ::: "memory"); __builtin_amdgcn_s_barrier(); asm volatile("" ::: "memory");
        f32x4 gv[2][2];
#pragma unroll
        for (int bj = 0; bj < 2; ++bj)
#pragma unroll
            for (int n = 0; n < 2; ++n) gv[bj][n] = *(const f32x4*)(gg + col0 + bj * HALF + 4 * n);
#pragma unroll
        for (int ai = 0; ai < 2; ++ai)
#pragma unroll
            for (int m = 0; m < 4; ++m) { const int rl = ai * HALF + wr * 64 + m * 16 + fr; const f32x4 p = *(const PG8_LAS f32x4*)(P + rl * 4);
                const float rstd = __builtin_amdgcn_rsqf(((p[0] + p[1]) + (p[2] + p[3])) * (1.0f / 256.0f) + EPS);
                bf16_t* rowp = MIXO + (size_t)(u.pm * BM + rl) * 1024 + col0;
#pragma unroll
                for (int bj = 0; bj < 2; ++bj) { const f32x4 v0 = acc[ai][bj][m][0] * rstd * gv[bj][0], v1 = acc[ai][bj][m][1] * rstd * gv[bj][1];
                    u32x4 w; w.x = cvt_pk_bf16(v0[0], v0[1]); w.y = cvt_pk_bf16(v0[2], v0[3]); w.z = cvt_pk_bf16(v1[0], v1[1]); w.w = cvt_pk_bf16(v1[2], v1[3]);
                    *(u32x4*)(rowp + bj * HALF) = w; } }
    }
};

template <class T, class = void> struct has_init { static constexpr bool value = false; };
template <class T> struct has_init<T, decltype((void)T::INIT)> { static constexpr bool value = true; };
struct OneUnit { int pm; __device__ __forceinline__ bool next(int i, Unit& u) const { if (i) return false; u.pm = pm; u.pn = 0; return true; } };
typedef int v8i_t __attribute__((ext_vector_type(8)));
typedef int v4i_t __attribute__((ext_vector_type(4)));
__device__ __forceinline__ const char* uptr(const char* p) { const unsigned long long v = (unsigned long long)p; const unsigned lo = (unsigned)__builtin_amdgcn_readfirstlane((int)(unsigned)v), hi = (unsigned)__builtin_amdgcn_readfirstlane((int)(unsigned)(v >> 32)); return (const char*)(((unsigned long long)hi << 32) | lo); }
__device__ __forceinline__ v8i_t ld8(const PG8_LAS unsigned char* p0, const PG8_LAS unsigned char* p1) { const v4i_t lo = *(const PG8_LAS v4i_t*)p0, hi = *(const PG8_LAS v4i_t*)p1; return __builtin_shufflevector(lo, hi, 0, 1, 2, 3, 4, 5, 6, 7); }
template <class Epi, bool ALIGN_EPI, bool GATHER, class Sched, int EB = 2>
__device__ __forceinline__ void gemm_phase(PG8_LAS unsigned char* lds, PG8_LAS int* tab, const Gemm g, const Sched& S, const Epi& E, int wave_in) {
    const bool use_e = (g.tile_e != nullptr);
    if (GATHER || use_e || g.ssq) {
        Unit uu; const int tp_ = wave_in * 64 + hw_lane();
        for (int i = 0; i < MAXU && S.next(i, uu); ++i) {
            if (tp_ == 0) tab[i] = use_e ? (int)__hip_atomic_load((const unsigned*)g.tile_e + uu.pm, RLX_AGENT) : 0;
            if (GATHER && tp_ < 256) tab[16 + 256 * i + tp_] = (int)__hip_atomic_load((const unsigned*)g.rowtok + uu.pm * 256 + tp_, RLX_AGENT);
            if (g.ssq && tp_ < 256) { const f32x4* p = (const f32x4*)(g.ssq + (size_t)(uu.pm * 256 + tp_) * 16); const f32x4 a = p[0], b = p[1], c = p[2], d = p[3];
                const float t = ((a[0] + a[1]) + (a[2] + a[3])) + ((b[0] + b[1]) + (b[2] + b[3])) + ((c[0] + c[1]) + (c[2] + c[3])) + ((d[0] + d[1]) + (d[2] + d[3]));
                tab[16 + 256 * i + tp_] = __builtin_bit_cast(int, __builtin_amdgcn_rsqf(t * (1.0f / 1024.0f) + EPS)); }
        }
        asm volatile("s_waitcnt vmcnt(0) lgkmcnt(0)" ::: "memory"); __syncthreads();
    }
    int tid_ = wave_in * 64 + hw_lane(); asm volatile("" : "+v"(tid_));
    const int tid = tid_, wid = __builtin_amdgcn_readfirstlane(tid >> 6), lane = tid & 63, wr = wid >> 2, wc = wid & 3, fr = lane & 15, fq = lane >> 4;
    int K_ = g.K; asm volatile("" : "+s"(K_));
    const int K = K_ * EB, nt = K / 128;
    int sR[2], sC[2];
    unsigned voffA[2], voffB[2];
#pragma unroll
    for (int i = 0; i < 2; ++i) { int R, C; stage_rc(tid * 16 + i * 8192, R, C); sR[i] = R; sC[i] = C; const int Rb = Epi::PERM ? ((R & ~31) + perm32(R & 31)) : R;
        voffA[i] = (unsigned)(R * K + C * 2); voffB[i] = (unsigned)(Rb * K + C * 2); }
    const unsigned kstep = 128u, d64 = (unsigned)(64 * K);
    const unsigned hstep = (unsigned)(HALF * K);
    const unsigned tstep = 2u * hstep;
    const unsigned hstepA = GATHER ? 0u : hstep;
    const __amdgpu_buffer_rsrc_t rW = __builtin_amdgcn_make_buffer_rsrc((void*)g.ws, 0, 0x7fffffff, 0x00020000);
    const unsigned baseA = (unsigned)((const unsigned char*)g.A - g.ws), baseB = (unsigned)((const unsigned char*)g.Bt - g.ws);
#define rA rW
#define rB rW
    const unsigned ldsw = (unsigned)wid * 1024u;
    constexpr int PSTEP = (EB == 2) ? 1024 : 16;
    const int aoff = lds_byte(wr * 64 + fr, (EB == 2) ? 8 * fq : 16 * fq), boff = lds_byte(wc * 32 + fr, (EB == 2) ? 8 * fq : 16 * fq);
    int boffB_ = boff + 4 * HTB; asm volatile("" : "+v"(boffB_));
    const PG8_LAS unsigned char* ldsB = lds + boffB_;
#define PG8_SA(b, h) (((b) * 2 + (h)) * HTB)
#define PG8_SB(b, h) ((4 + (b) * 2 + (h)) * HTB)
#define PG8_SBR(b, h) (((b) * 2 + (h)) * HTB)
#define PG8_STAGE(bufoff, rsrc, soff, voff) do { _Pragma("unroll") for (int _i = 0; _i < 2; ++_i) \
        __builtin_amdgcn_raw_ptr_buffer_load_lds(rsrc, (PG8_LAS void*)(lds + (bufoff) + ldsw + _i * 8192), 16, (int)(voff)[0], (int)((soff) + (unsigned)_i * d64), 0, 0); } while (0)
#define PG8_STAGE_A(bufoff, rsrc, soff, UI, H) do { if constexpr (GATHER) { _Pragma("unroll") for (int _i = 0; _i < 2; ++_i) { \
        const unsigned go_ = (unsigned)(tab[16 + 256 * (UI) + (H) * HALF + sR[_i]] * K + sC[_i] * 2); \
        __builtin_amdgcn_raw_ptr_buffer_load_lds(rsrc, (PG8_LAS void*)(lds + (bufoff) + ldsw + _i * 8192), 16, (int)go_, (int)(soff), 0, 0); } } else PG8_STAGE(bufoff, rsrc, soff, voffA); } while (0)
#define PG8_LDA(dst, b, h) do { if constexpr (EB == 2) { _Pragma("unroll") for (int m = 0; m < 4; ++m) _Pragma("unroll") for (int k = 0; k < 2; ++k) dst[m][k] = *(const PG8_LAS bf16x8*)(lds + PG8_SA(b, h) + aoff + m * 2048 + k * PSTEP); } \
        else { _Pragma("unroll") for (int m = 0; m < 4; ++m) dst##8[m] = ld8(lds + PG8_SA(b, h) + aoff + m * 2048, lds + PG8_SA(b, h) + aoff + m * 2048 + PSTEP); } } while (0)
#define PG8_LDB(dst, b, h) do { if constexpr (EB == 2) { _Pragma("unroll") for (int n = 0; n < 2; ++n) _Pragma("unroll") for (int k = 0; k < 2; ++k) dst[n][k] = *(const PG8_LAS bf16x8*)(ldsB + PG8_SBR(b, h) + n * 2048 + k * PSTEP); } \
        else { _Pragma("unroll") for (int n = 0; n < 2; ++n) dst##8[n] = ld8(ldsB + PG8_SBR(b, h) + n * 2048, ldsB + PG8_SBR(b, h) + n * 2048 + PSTEP); } } while (0)
#define PG8_MMA(ai, bj, At, Bt) do { __builtin_amdgcn_s_setprio(1); _Pragma("unroll") for (int m = 0; m < 4; ++m) _Pragma("unroll") for (int n = 0; n < 2; ++n) { \
        if constexpr (EB == 2) { _Pragma("unroll") for (int k = 0; k < 2; ++k) acc[ai][bj][m][n] = __builtin_amdgcn_mfma_f32_16x16x32_bf16(Bt[n][k], At[m][k], acc[ai][bj][m][n], 0, 0, 0); } \
        else acc[ai][bj][m][n] = __builtin_amdgcn_mfma_scale_f32_16x16x128_f8f6f4(Bt##8[n], At##8[m], acc[ai][bj][m][n], 0, 0, 0, 0x79797979  , 0, 0x7f7f7f7f  ); } \
        __builtin_amdgcn_s_setprio(0); } while (0)
#define PG8_WAIT_V(n) asm volatile("s_waitcnt vmcnt(" #n ")" ::: "memory")
#define PG8_WAIT_L(n) asm volatile("s_waitcnt lgkmcnt(" #n ")" ::: "memory")
#define PG8_BAR __builtin_amdgcn_s_barrier()
#define PG8_SCHED __builtin_amdgcn_sched_barrier(0)
#define PG8_ABASE(pm_) (baseA + (GATHER ? 0u : (unsigned)(pm_) * tstep))
#define PG8_BBASE(ui_, pn_) (baseB + (use_e ? (unsigned)tab[(ui_)] * (unsigned)(g.estride * EB) : 0u) + (unsigned)(pn_) * tstep)
    Unit cur, nxt; int ui = 0;
    if (!S.next(0, cur)) return;
    cur.ui = 0;
    float zero_ = 0.f; asm volatile("" : "+v"(zero_));
    f32x4 acc[2][2][4][2];
    if constexpr (has_init<Epi>::value) { E.init(acc, cur, wr, wc, fr, fq); }
    else {
#pragma unroll
    for (int a = 0; a < 2; ++a)
#pragma unroll
        for (int b = 0; b < 2; ++b)
#pragma unroll
            for (int m = 0; m < 4; ++m)
#pragma unroll
                for (int n = 0; n < 2; ++n) acc[a][b][m][n] = (f32x4){zero_, zero_, zero_, zero_}; }
    bf16x8 At[4][2], B0[2][2], B1[2][2];
    v8i_t At8[4], B08[2], B18[2];
    (void)At; (void)B0; (void)B1; (void)At8; (void)B08; (void)B18;
    unsigned cA = PG8_ABASE(cur.pm), cB = PG8_BBASE(0, cur.pn);
    PG8_STAGE(PG8_SB(0, 0), rB, cB, voffB); PG8_STAGE(PG8_SB(0, 1), rB, cB + hstep, voffB); PG8_STAGE_A(PG8_SA(0, 0), rA, cA, 0, 0); PG8_STAGE_A(PG8_SA(0, 1), rA, cA + hstepA, 0, 1);
    if (wr == 1) PG8_BAR;
    PG8_WAIT_V(2); PG8_BAR;
    PG8_STAGE(PG8_SB(1, 0), rB, cB + kstep, voffB); PG8_STAGE_A(PG8_SA(1, 0), rA, cA + kstep, 0, 0); PG8_STAGE(PG8_SB(1, 1), rB, cB + hstep + kstep, voffB);
    PG8_WAIT_V(6); PG8_BAR;
    for (;;) {
        const bool has_next = S.next(ui + 1, nxt); nxt.ui = ui + 1;
        const unsigned nA = has_next ? PG8_ABASE(nxt.pm) : cA, nB = has_next ? PG8_BBASE(ui + 1, nxt.pn) : cB;
#pragma unroll 1
        for (int t = 0; t < nt; t += 2) {
            const bool last = (t == nt - 2);
            const unsigned a1 = cA + (unsigned)(t + 1) * kstep;
            const unsigned a2 = last ? nA : cA + (unsigned)(t + 2) * kstep, b2 = last ? nB : cB + (unsigned)(t + 2) * kstep;
            const unsigned a3 = a2 + kstep, b3 = b2 + kstep;
            const int uis = (last && has_next) ? ui + 1 : ui; (void)uis;
            PG8_LDB(B0, 0, 0); PG8_LDB(B1, 0, 1); PG8_SCHED; PG8_LDA(At, 0, 0); PG8_STAGE_A(PG8_SA(1, 1), rA, a1 + hstepA, ui, 1);
            PG8_WAIT_V(8); PG8_WAIT_L(0); PG8_BAR; PG8_MMA(0, 0, At, B0); PG8_MMA(0, 1, At, B1); PG8_BAR; PG8_SCHED;
            PG8_LDA(At, 0, 1); PG8_STAGE(PG8_SB(0, 0), rB, b2, voffB); PG8_STAGE(PG8_SB(0, 1), rB, b2 + hstep, voffB); PG8_STAGE_A(PG8_SA(0, 0), rA, a2, uis, 0);
            PG8_WAIT_V(8); PG8_WAIT_L(0); PG8_BAR; PG8_MMA(1, 0, At, B0); PG8_MMA(1, 1, At, B1); PG8_BAR; PG8_SCHED;
            PG8_LDB(B0, 1, 0); PG8_LDB(B1, 1, 1); PG8_SCHED; PG8_LDA(At, 1, 0); PG8_STAGE_A(PG8_SA(0, 1), rA, a2 + hstepA, uis, 1);
            PG8_WAIT_V(8); PG8_WAIT_L(0); PG8_BAR; PG8_MMA(0, 0, At, B0); PG8_MMA(0, 1, At, B1); PG8_BAR; PG8_SCHED;
            PG8_LDA(At, 1, 1); PG8_STAGE(PG8_SB(1, 0), rB, b3, voffB); PG8_STAGE(PG8_SB(1, 1), rB, b3 + hstep, voffB); PG8_STAGE_A(PG8_SA(1, 0), rA, a3, uis, 0);
            PG8_WAIT_V(8); PG8_WAIT_L(0); PG8_BAR; PG8_MMA(1, 0, At, B0); PG8_MMA(1, 1, At, B1); PG8_BAR; PG8_SCHED;
        }
        if constexpr (ALIGN_EPI) { if (wr == 0) PG8_BAR; }
        if constexpr (!Epi::AFTER_DRAIN) { const int el_ = hw_lane(); E(acc, cur, wr, wc, el_ & 15, el_ >> 4); }
        if (!has_next) break;
        if constexpr (has_init<Epi>::value) { const int el2_ = hw_lane(); E.init(acc, nxt, wr, wc, el2_ & 15, el2_ >> 4); }
        else { float z2_ = 0.f; asm volatile("" : "+v"(z2_));
#pragma unroll
        for (int a = 0; a < 2; ++a)
#pragma unroll
            for (int b = 0; b < 2; ++b)
#pragma unroll
                for (int m = 0; m < 4; ++m)
#pragma unroll
                    for (int n = 0; n < 2; ++n) acc[a][b][m][n] = (f32x4){z2_, z2_, z2_, z2_}; }
        cur = nxt; cA = nA; cB = nB; ++ui;
        if constexpr (ALIGN_EPI) { if (wr == 1) PG8_BAR; }
    }
    PG8_WAIT_V(0);
    if constexpr (!ALIGN_EPI) { if (wr == 0) PG8_BAR; }
    PG8_BAR;
    if constexpr (Epi::AFTER_DRAIN) { const int el_ = hw_lane(); E.fused(acc, cur, wr, wc, el_ & 15, el_ >> 4, lds, wid, el_); }
#undef PG8_SA
#undef PG8_SB
#undef PG8_STAGE
#undef PG8_STAGE_A
#undef PG8_LDA
#undef PG8_LDB
#undef PG8_MMA
#undef PG8_WAIT_V
#undef PG8_WAIT_L
#undef PG8_BAR
#undef PG8_SCHED
#undef PG8_ABASE
#undef PG8_BBASE
#undef rA
#undef rB
}
}

constexpr size_t MiB = 1u << 20;
constexpr size_t WS_CTL = 0, CTL_ZERO_BYTES = 1 * MiB;
constexpr size_t WS_TAB = 1 * MiB, TAB_L = 10 * MiB;
constexpr size_t TB_KMAT = 0, TB_WIN = 1 * MiB, TB_WOUT = 5 * MiB, TB_APT = 9 * MiB, TB_RGWX = 9 * MiB + 65536, TB_RGWA = 9 * MiB + 131072, TB_WGLU = 9 * MiB + 262144;
constexpr size_t WS_WINT = 21 * MiB, WINT_L = (size_t)D_IN * D * 2;
constexpr size_t WS_WOUTT = 30 * MiB, WOUTT_L = (size_t)D * D * 2;
constexpr size_t WS_F13 = 34 * MiB, WS_F2 = 45 * MiB;
constexpr size_t WS_M2 = 51 * MiB, WS_M13 = 95 * MiB;
constexpr size_t E13 = (size_t)2 * FF * D, E2 = (size_t)D * FF;
constexpr size_t WS_OVL = 183 * MiB;
constexpr size_t WS_XN = WS_OVL, WS_QK = 215 * MiB, WS_VT = 247 * MiB, WS_RGS = 263 * MiB, WS_RGH = 287 * MiB, WS_RGA = 303 * MiB, WS_MIX = 319 * MiB, WS_S5Y = 351 * MiB,
                 WS_SLOC = 359 * MiB, WS_RGCP = 361 * MiB, WS_RGCH = 361 * MiB + 262144;
constexpr size_t WS_KC = WS_QK + 16 * MiB;
constexpr size_t WS_ACT0 = 215 * MiB, WS_ACT1 = 215 * MiB;
constexpr size_t WS_SSQ = 362 * MiB;
constexpr size_t WS_XNM = 1 * MiB, WS_TOKINFO = 36 * MiB, WS_POS = 36 * MiB + 262144, WS_ROWTOK = 36 * MiB + 524288, WS_YEXP = 95 * MiB;
constexpr size_t WS_HG8 = 320 * MiB;
constexpr size_t WS_END = 370 * MiB;
static_assert(WS_ACT1 + (size_t)PMAX * FF <= WS_HG8 && WS_HG8 + (size_t)PMAX * D <= WS_SSQ && WS_YEXP + (size_t)PMAX * D * 2 <= WS_OVL && WS_ACT0 + (size_t)M * FF * 2 <= WS_END, "ws map");
static_assert(WS_M13 + NE * E13 * 2 <= WS_OVL && WS_M2 + NE * E2 * 2 <= WS_M13 && WS_F2 + E2 * 2 <= WS_M2 && WS_F13 + E13 * 2 <= WS_F2, "ws map weights");
constexpr int CW_TMO = 0, CW_BAR = 4096, CW_CNT = 8192, CW_ROUTE = 12288, CW_TILEE = 12544;

constexpr int RING_BYTES = 131072, TAB_OFF = RING_BYTES, TAB_BYTES = 12544, MISC_OFF = TAB_OFF + TAB_BYTES, LDS_BYTES = 147456;
static_assert(MISC_OFF + 128 <= LDS_BYTES, "LDS map");
constexpr int NWAVES = 8;

#define XB_TMO      128
#define XB_XCNT(j)  (256  + 64 * (j))
#define XB_XSUB(j)  (1280 + 64 * (j))
#define XB_XGEN(j)  (2304 + 64 * (j))
#define XB_TOP      3328
#define XB_TOPGEN   3392
#define XCD_BAR_WORDS 3456
#define XB_SPIN_CAP (1u << 18)
__device__ __forceinline__ unsigned xb_ld(unsigned* p)              { return __hip_atomic_load(p, __ATOMIC_RELAXED, __HIP_MEMORY_SCOPE_AGENT); }
__device__ __forceinline__ unsigned xb_add(unsigned* p, unsigned v) { return __hip_atomic_fetch_add(p, v, __ATOMIC_RELAXED, __HIP_MEMORY_SCOPE_AGENT); }
__device__ __forceinline__ unsigned xb_xcc_id() { return (unsigned)__builtin_amdgcn_s_getreg((3 << 11) | 20) & 0xFu; }
#define XB_SPIN(cond, bar) do { unsigned _sp = 0; while (cond) { __builtin_amdgcn_s_sleep(1); \
    if ((++_sp & 255u) == 0u) { if (xb_ld(&(bar)[XB_TMO])) break; if (_sp > XB_SPIN_CAP) { atomicAdd(&(bar)[XB_TMO], 1u); break; } } } } while (0)
struct XcdBarrier { unsigned* bar; unsigned x; volatile LAS unsigned* st; bool leader; };
__device__ __forceinline__ XcdBarrier xcd_barrier_post(unsigned* bar, volatile LAS unsigned* st, bool leader) {
    XcdBarrier b; b.bar = bar; b.x = xb_xcc_id(); b.st = st; b.leader = leader;
    if (b.leader) st[12] = xb_add(&bar[XB_XCNT(b.x)], 1u);
    return b;
}
__device__ __forceinline__ void xcd_barrier_complete(unsigned* bar, unsigned x, unsigned& nloc, unsigned& nx, bool& uni) {
    const unsigned G = gridDim.x * gridDim.y * gridDim.z;
    unsigned sum, cnt, mine, sp = 0u;
    for (;;) {
        sum = 0u; cnt = 0u; mine = 0u;
#pragma unroll
        for (unsigned j = 0; j < 16; ++j) { const unsigned c = xb_ld(&bar[XB_XCNT(j)]); sum += c; cnt += (c > 0u) ? 1u : 0u; mine = (j == x) ? c : mine; }
        if (sum == G) break;
        __builtin_amdgcn_s_sleep(1);
        if ((++sp & 255u) == 0u) { if (xb_ld(&bar[XB_TMO])) break; if (sp > XB_SPIN_CAP) { atomicAdd(&bar[XB_TMO], 1u); break; } }
    }
    nloc = mine > 0u ? mine : 1u; nx = cnt > 0u ? cnt : 1u;
    uni = (G % 8u == 0u);
#pragma unroll
    for (unsigned j = 0; j < 16; ++j) { const unsigned c = xb_ld(&bar[XB_XCNT(j)]); uni = uni && (c == (j < 8u ? G / 8u : 0u)); }
}
__device__ __forceinline__ void xcd_barrier(const XcdBarrier& b) {
    asm volatile("s_waitcnt vmcnt(0)" ::: "memory");
    __syncthreads();
    if (b.leader) {
        unsigned* bar = b.bar;
        __builtin_amdgcn_s_waitcnt(0);
        unsigned nloc = b.st[0], nx = b.st[1];
        if (nloc == 0u) { bool uni; xcd_barrier_complete(bar, b.x, nloc, nx, uni); b.st[0] = nloc; b.st[1] = nx;
            b.st[13] = uni ? (b.st[12] * 8u + b.x) + 1u : 0u; }
        const unsigned old = xb_add(&bar[XB_XSUB(b.x)], 1u);
        const unsigned gen = old / nloc;
        if (old + 1u == (gen + 1u) * nloc) {
            __builtin_amdgcn_fence(__ATOMIC_RELEASE, "agent");
            asm volatile("s_waitcnt vmcnt(0)" ::: "memory");
            const unsigned og = xb_add(&bar[XB_TOP], 1u);
            const unsigned tg = og / nx;
            if (og + 1u == (tg + 1u) * nx) xb_add(&bar[XB_TOPGEN], 1u);
            else XB_SPIN(xb_ld(&bar[XB_TOPGEN]) == tg, bar);
            __builtin_amdgcn_fence(__ATOMIC_ACQUIRE, "agent");
            xb_add(&bar[XB_XGEN(b.x)], 1u);
            asm volatile("s_waitcnt vmcnt(0)" ::: "memory");
        } else {
            XB_SPIN(xb_ld(&bar[XB_XGEN(b.x)]) == gen, bar);
            __builtin_amdgcn_fence(__ATOMIC_ACQUIRE, "agent");
            asm volatile("s_waitcnt vmcnt(0)" ::: "memory");
        }
    }
    __syncthreads();
}

struct Inputs {
    const float *x, *norm_mix_g, *w_in, *rel_bias, *rg_conv_w, *rg_conv_b, *rg_wx, *rg_bx, *rg_wa, *rg_ba, *rg_lambda,
                *s5_a_re, *s5_a_im, *s5_log_dt, *s5_b_re, *s5_b_im, *s5_c_re, *s5_c_im, *s5_d, *s5_w_glu, *g_group, *w_out, *norm_ffn_g,
                *ffn_w1, *ffn_w3, *ffn_w2, *moe_router, *moe_w1, *moe_w3, *moe_w2, *final_norm_g;
};
struct Args { Inputs in; float* out; unsigned char* ws; int ph_lo, ph_hi; };
struct Frame {
    LAS unsigned char* lds;
    unsigned char* ws;
    gu32* ctl;
    int tid, lane, wave, G, wg;
    const __attribute__((address_space(4))) struct Args* ka;
    float* out;
};
template <class T> __device__ __forceinline__ T* wsp(const Frame& F, size_t off) { return (T*)(F.ws + off); }

__device__ __forceinline__ void p0_transpose_item(const float* W, int K, int N, bf16_t* WT, int row_off, int mode, LAS float* scr, int item, int lane) {
    const int nblk = N / 32, kb = item / nblk, nb = item % nblk, k0 = 64 * kb, n0 = 32 * nb;
#pragma unroll 8
    for (int i = 0; i < 32; ++i) { const int kk = 2 * i + (lane >> 5); scr[kk * 33 + (lane & 31)] = W[(size_t)(k0 + kk) * N + n0 + (lane & 31)]; }
    LDS_WAIT(); asm volatile("" ::: "memory");
    const int c = lane & 7;
    const int drow0 = (mode == 0) ? (row_off + n0) : (256 * (n0 >> 7) + (n0 & 127) + (mode == 2 ? 128 : 0));
#pragma unroll
    for (int j = 0; j < 4; ++j) { const int n = (lane >> 3) + 8 * j; const LAS float* s = scr + (8 * c) * 33 + n;
        u32x4 o; o.x = pk2(s[0 * 33], s[1 * 33]); o.y = pk2(s[2 * 33], s[3 * 33]); o.z = pk2(s[4 * 33], s[5 * 33]); o.w = pk2(s[6 * 33], s[7 * 33]);
        *(GAS u32x4*)(WT + (size_t)(drow0 + n) * K + k0 + 8 * c) = o; }
    LDS_WAIT(); asm volatile("" ::: "memory");
}
struct TrJob { const float* W; bf16_t* WT; int K, N, mode, fp8; const float* gk; };
__device__ __forceinline__ void tr_load(const TrJob& j, int tile, int tid, f32x4 (&v)[8]) {
    const int ntn = j.N >> 7, kb = tile / ntn, nb = tile - kb * ntn;
    const float* src = j.W + (size_t)(128 * kb + (tid >> 5)) * j.N + 128 * nb + 4 * (tid & 31);
#pragma unroll
    for (int i = 0; i < 8; ++i) v[i] = __builtin_nontemporal_load((const f32x4*)(src + (size_t)(16 * i) * j.N));
}
__device__ __forceinline__ void tr_store(const TrJob& j, int tile, int tid, const f32x4 (&v)[8], LAS unsigned* T) {
    const int ntn = j.N >> 7, kb = tile / ntn, nb = tile - kb * ntn;
#pragma unroll
    for (int i = 0; i < 8; ++i) { const int k = (tid >> 5) + 16 * i; const int dw = (2 * (tid & 31)) ^ (2 * ((k >> 3) & 15));
        const float gq = j.gk ? j.gk[128 * kb + k] : 1.0f;
        *(LAS u32x2*)(T + k * 64 + dw) = (u32x2){pk2(v[i].x * gq, v[i].y * gq), pk2(v[i].z * gq, v[i].w * gq)}; }
    LDS_WAIT(); __syncthreads();
    const int drow0 = (j.mode == 0) ? 128 * nb : (256 * nb + (j.mode == 2 ? 128 : 0));
    const LAS unsigned short* T16 = (const LAS unsigned short*)T;
    if (j.fp8) {
        const int kc = tid & 7;
#pragma unroll
        for (int r = 0; r < 2; ++r) { const int n = (tid >> 3) + 64 * r; unsigned o4[4];
#pragma unroll
            for (int q4 = 0; q4 < 4; ++q4) { float f[4];
#pragma unroll
                for (int q = 0; q < 4; ++q) { const int k = 16 * kc + 4 * q4 + q; const int e0 = 2 * ((n >> 1) ^ (2 * ((k >> 3) & 15))) + (n & 1); f[q] = bf2f(T16[k * 128 + e0]) * 64.0f; }
                o4[q4] = pg8::pk4_fp8(f[0], f[1], f[2], f[3]); }
            *(GAS u32x4*)((unsigned char*)j.WT + (size_t)(drow0 + n) * j.K + 128 * kb + 16 * kc) = (u32x4){o4[0], o4[1], o4[2], o4[3]}; }
    } else {
    const int kc = tid & 15;
#pragma unroll
    for (int r = 0; r < 4; ++r) { const int n = (tid >> 4) + 32 * r; const int e0 = 2 * ((n >> 1) ^ (2 * kc)) + (n & 1);
        unsigned h[8];
#pragma unroll
        for (int q = 0; q < 8; ++q) h[q] = T16[(8 * kc + q) * 128 + e0];
        u32x4 o; o.x = h[0] | (h[1] << 16); o.y = h[2] | (h[3] << 16); o.z = h[4] | (h[5] << 16); o.w = h[6] | (h[7] << 16);
        *(GAS u32x4*)(j.WT + (size_t)(drow0 + n) * j.K + 128 * kb + 8 * kc) = o; }
    }
    LDS_WAIT(); __syncthreads();
}
__device__ __forceinline__ void rms_row_to_bf16(int lane, const float* xrow, const float* g, bf16_t* orow) {
    const GAS f32x4* xr = (const GAS f32x4*)xrow + lane; const GAS f32x4* gr = (const GAS f32x4*)g + lane;
    f32x4 v[4]; float s = 0.f;
#pragma unroll
    for (int j = 0; j < 4; ++j) { v[j] = xr[64 * j]; s += (v[j].x * v[j].x + v[j].y * v[j].y) + (v[j].z * v[j].z + v[j].w * v[j].w); }
    const float rstd = 1.f / sqrtf(wave_sum(s) * (1.f / D) + EPS);
    GAS unsigned long long* o8 = (GAS unsigned long long*)orow + lane;
#pragma unroll
    for (int j = 0; j < 4; ++j) { const f32x4 gg = gr[64 * j]; o8[64 * j] = (unsigned long long)pk2(v[j].x * rstd * gg.x, v[j].y * rstd * gg.y) | ((unsigned long long)pk2(v[j].z * rstd * gg.z, v[j].w * rstd * gg.w) << 32); }
}
__device__ __forceinline__ void stream_phase(Frame& F, const float* src, bf16_t* dst, float* ssq) {
    const int gw = F.wg * NWAVES + F.wave, NGW = F.G * NWAVES;
    constexpr int RB = 4;
    for (int m0 = gw; m0 < M; m0 += NGW * RB) {
        f32x4 v[RB][4]; float s[RB];
#pragma unroll
        for (int q = 0; q < RB; ++q) { const int m = m0 + q * NGW; const GAS f32x4* xr = (const GAS f32x4*)(src + (size_t)(m < M ? m : m0) * D) + F.lane;
#pragma unroll
            for (int j = 0; j < 4; ++j) v[q][j] = xr[64 * j]; }
#pragma unroll
        for (int q = 0; q < RB; ++q) { float a = 0.f;
#pragma unroll
            for (int j = 0; j < 4; ++j) a += (v[q][j].x * v[q][j].x + v[q][j].y * v[q][j].y) + (v[q][j].z * v[q][j].z + v[q][j].w * v[q][j].w);
            s[q] = a; }
#pragma unroll
        for (int o = 1; o < 64; o <<= 1)
#pragma unroll
            for (int q = 0; q < RB; ++q) s[q] += shx(s[q], o);
#pragma unroll
        for (int q = 0; q < RB; ++q) { const int m = m0 + q * NGW; if (m >= M) break;
            GAS unsigned long long* o8 = (GAS unsigned long long*)(dst + (size_t)m * D) + F.lane;
#pragma unroll
            for (int j = 0; j < 4; ++j) o8[64 * j] = (unsigned long long)pk2(v[q][j].x, v[q][j].y) | ((unsigned long long)pk2(v[q][j].z, v[q][j].w) << 32);
            if (F.lane < 16) ssq[(size_t)m * 16 + F.lane] = F.lane == 0 ? s[q] : 0.f; }
    }
}
__device__ __forceinline__ void s5_pow(float are, float aim, float dt, int k, float& pr, float& pi) {
    const float mag = expf(are * dt * (float)k);
    double ph = (double)aim * (double)dt * (double)k; ph -= 6.283185307179586476925 * rint(ph * 0.15915494309189533577);
    float s, c; sincosf((float)ph, &s, &c); pr = mag * c; pi = mag * s;
}
__device__ __forceinline__ void s5_q(float are, float aim, float dt, float& qr, float& qi) {
    const float zr = are * dt, zi = aim * dt;
    float s, c; sincosf(zi, &s, &c); const float sh = sinf(0.5f * zi);
    const float em1 = expm1f(zr), e = em1 + 1.0f;
    const float nr = em1 * c - 2.0f * sh * sh, ni = e * s;
    const float den = are * are + aim * aim;
    qr = (nr * are + ni * aim) / den; qi = (ni * are - nr * aim) / den;
}
__device__ __forceinline__ void p0_tables(Frame& F, int l) {
    const int gt = F.wg * 512 + F.tid, NT = F.G * 512;
    const float* are_ = F.ka->in.s5_a_re + l * S5G * S5P; const float* aim_ = F.ka->in.s5_a_im + l * S5G * S5P; const float* ldt_ = F.ka->in.s5_log_dt + l * S5G;
    const float* bre_ = F.ka->in.s5_b_re + (size_t)l * S5G * S5P * S5C; const float* bim_ = F.ka->in.s5_b_im + (size_t)l * S5G * S5P * S5C;
    const float* cre_ = F.ka->in.s5_c_re + (size_t)l * S5G * S5C * S5P; const float* cim_ = F.ka->in.s5_c_im + (size_t)l * S5G * S5C * S5P;
    unsigned char* tb = F.ws + WS_TAB + l * TAB_L;
    bf16_t* KMAT = (bf16_t*)(tb + TB_KMAT); bf16_t* WIN = (bf16_t*)(tb + TB_WIN); bf16_t* WOUT = (bf16_t*)(tb + TB_WOUT); float* APT = (float*)(tb + TB_APT);
    for (int it = gt; it < S5G * S5P * CHUNK; it += NT) {
        const int s = it & 63, p = (it >> 6) & 63, g = it >> 12;
        const float are = are_[g * S5P + p], aim = aim_[g * S5P + p], dt = expf(ldt_[g]);
        float pr, pi, qr, qi; s5_pow(are, aim, dt, CHUNK - 1 - s, pr, pi); s5_q(are, aim, dt, qr, qi);
        const float wr_ = pr * qr - pi * qi, wi_ = pr * qi + pi * qr;
        bf16_t* o_re = WIN + ((size_t)(g * 128 + p) * 1024 + s * 16); bf16_t* o_im = WIN + ((size_t)(g * 128 + 64 + p) * 1024 + s * 16);
#pragma unroll
        for (int ci = 0; ci < 16; ++ci) { const float br = bre_[(g * S5P + p) * S5C + ci], bi = bim_[(g * S5P + p) * S5C + ci];
            o_re[ci] = (bf16_t)f2bf(wr_ * br - wi_ * bi); o_im[ci] = (bf16_t)f2bf(wr_ * bi + wi_ * br); }
        if (s == 0) { float ar, ai; s5_pow(are, aim, dt, CHUNK, ar, ai); APT[(g * S5P + p) * 2] = ar; APT[(g * S5P + p) * 2 + 1] = ai; }
    }
    for (int it = gt; it < S5G * CHUNK * S5P; it += NT) {
        const int p = it & 63, t = (it >> 6) & 63, g = it >> 12;
        float pr, pi; s5_pow(are_[g * S5P + p], aim_[g * S5P + p], expf(ldt_[g]), t + 1, pr, pi);
        bf16_t* o = WOUT + (size_t)(g * 1024 + t * 16) * 128 + p;
#pragma unroll 4
        for (int co = 0; co < 16; ++co) { const float cr = cre_[(g * S5C + co) * S5P + p], ci = cim_[(g * S5C + co) * S5P + p];
            o[co * 128] = (bf16_t)f2bf(cr * pr - ci * pi); o[co * 128 + 64] = (bf16_t)f2bf(-(cr * pi + ci * pr)); }
    }
    { LAS float* wl = (LAS float*)F.lds;
      LAS float* Cr = wl + 256; LAS float* Ci = Cr + 1024; LAS float* Br = Ci + 1024; LAS float* Bi = Br + 1024;
      const int half = F.tid >> 8, co = (F.tid >> 4) & 15, ci = F.tid & 15;
      for (int item = F.wg; item < S5G * 33; item += F.G) {
          const int g = item / 33, li0 = 2 * (item % 33);
          for (int i = F.tid; i < 1024; i += 512) { Cr[i] = cre_[g * 1024 + i]; Ci[i] = cim_[g * 1024 + i]; Br[i] = bre_[g * 1024 + i]; Bi[i] = bim_[g * 1024 + i]; }
          if ((F.tid & 255) < 64) { const int p = F.tid & 63, li = li0 + half; float wr_ = 0.f, wi_ = 0.f;
              if (li >= 1 && li <= 64) { const float are = are_[g * S5P + p], aim = aim_[g * S5P + p], dt = expf(ldt_[g]); float pr, pi, qr, qi; s5_pow(are, aim, dt, li - 1, pr, pi); s5_q(are, aim, dt, qr, qi);
                  wr_ = pr * qr - pi * qi; wi_ = pr * qi + pi * qr; }
              wl[(half * 64 + p) * 2] = wr_; wl[(half * 64 + p) * 2 + 1] = wi_; }
          LDS_WAIT(); __syncthreads();
          const int li = li0 + half;
          if (li <= 64) { float a = 0.f;
#pragma unroll 8
              for (int p = 0; p < S5P; ++p) { const float wr_ = wl[(half * 64 + p) * 2], wi_ = wl[(half * 64 + p) * 2 + 1];
                  const float cr = Cr[co * 64 + p], cim = Ci[co * 64 + p], br = Br[p * 16 + ci], bi = Bi[p * 16 + ci];
                  a += (cr * wr_ - cim * wi_) * br - (cr * wi_ + cim * wr_) * bi; }
              KMAT[(size_t)((g * 65 + li) * 16 + co) * 16 + ci] = (bf16_t)f2bf(a); }
          __syncthreads();
      } }
    bf16_t* WXT = (bf16_t*)(tb + TB_RGWX); bf16_t* WAT = (bf16_t*)(tb + TB_RGWA);
    const float* wx = F.ka->in.rg_wx + (size_t)l * 4 * 64 * 64; const float* wa = F.ka->in.rg_wa + (size_t)l * 4 * 64 * 64;
    for (int it = gt; it < 4 * 64 * 64; it += NT) { const int i = it & 63, o = (it >> 6) & 63, hb = it >> 12;
        WXT[it] = (bf16_t)f2bf(wx[(hb * 64 + i) * 64 + o]); WAT[it] = (bf16_t)f2bf(wa[(hb * 64 + i) * 64 + o]); }
}
__device__ __forceinline__ TrJob p0_job(const Frame& F, int it, int& tile) {
    constexpr int T_IN = (D / 128) * (D_IN / 128), T_OUT = (D / 128) * (D / 128), T_UP = (D / 128) * (FF / 128), T_DN = (FF / 128) * (D / 128), T_GLU = 4;
    int r = it; TrJob j;
    if (r < 2 * T_IN) { const int l = r / T_IN; tile = r % T_IN; j = TrJob{F.ka->in.w_in + (size_t)l * D * D_IN, wsp<bf16_t>(F, WS_WINT + l * WINT_L), D, D_IN, 0, 0, F.ka->in.norm_mix_g + l * D}; return j; } r -= 2 * T_IN;
    if (r < 2 * T_OUT) { const int l = r / T_OUT; tile = r % T_OUT; j = TrJob{F.ka->in.w_out + (size_t)l * D * D, wsp<bf16_t>(F, WS_WOUTT + l * WOUTT_L), D, D, 0, 0, nullptr}; return j; } r -= 2 * T_OUT;
    if (r < 2 * T_GLU) { const int l = r / T_GLU; tile = r % T_GLU; j = TrJob{F.ka->in.s5_w_glu + (size_t)l * 256 * 256, wsp<bf16_t>(F, WS_TAB + l * TAB_L + TB_WGLU), 256, 256, 0, 0, nullptr}; return j; } r -= 2 * T_GLU;
    int e, part;
    if (r < 2 * T_UP + T_DN) { e = 0; part = r / T_UP; r -= part * T_UP; }
    else { r -= 2 * T_UP + T_DN;
        if (r < NE * 2 * T_UP) { e = 1 + r / (2 * T_UP); r -= (e - 1) * 2 * T_UP; part = r / T_UP; r -= part * T_UP; }
        else { r -= NE * 2 * T_UP; e = 1 + r / T_DN; r -= (e - 1) * T_DN; part = 2; } }
    tile = r;
    if (part == 2) { const float* w2 = e ? F.ka->in.moe_w2 + (size_t)(e - 1) * FF * D : F.ka->in.ffn_w2; bf16_t* d2 = e ? (bf16_t*)(F.ws + WS_M2 + (size_t)(e - 1) * E2) : wsp<bf16_t>(F, WS_F2);
        j = TrJob{w2, d2, FF, D, 0, e ? 1 : 0, nullptr}; return j; }
    const float* w13 = part ? (e ? F.ka->in.moe_w3 + (size_t)(e - 1) * D * FF : F.ka->in.ffn_w3) : (e ? F.ka->in.moe_w1 + (size_t)(e - 1) * D * FF : F.ka->in.ffn_w1);
    bf16_t* d13 = e ? (bf16_t*)(F.ws + WS_M13 + (size_t)(e - 1) * E13) : wsp<bf16_t>(F, WS_F13);
    j = TrJob{w13, d13, D, FF, 1 + part, e ? 1 : 0, e ? nullptr : F.ka->in.norm_ffn_g}; return j;
}
__device__ __forceinline__ void convert_jobs(Frame& F, int first, int end, int stride) {
    LAS unsigned* T = (LAS unsigned*)F.lds;
    f32x4 v[8]; int tile = 0, ntile = 0; TrJob cur{}, nxt{};
    int it = first;
    if (it < end) { cur = p0_job(F, it, tile); tr_load(cur, tile, F.tid, v); }
    while (it < end) {
        f32x4 w[8];
#pragma unroll
        for (int i = 0; i < 8; ++i) w[i] = v[i];
        const int itn = it + stride;
        if (itn < end) { nxt = p0_job(F, itn, ntile); tr_load(nxt, ntile, F.tid, v); }
        tr_store(cur, tile, F.tid, w, T);
        cur = nxt; tile = ntile; it = itn;
    }
}
constexpr int JOB_MOE0 = 952, JOB_W2 = JOB_MOE0 + NE * 352, JOB_END = 5176, BG_P0 = 768;
constexpr int BG_A0 = JOB_MOE0 + BG_P0;
constexpr int BG_C0 = BG_A0 + 768;
constexpr int BG_D0 = BG_C0 + 512;
static_assert(BG_D0 + 768 == JOB_W2 && JOB_W2 + NE * 176 == JOB_END && BG_P0 == 2 * 3 * (256 - S5G * 8), "background conversion slots cover every expert tile");
constexpr int BG_F_PER = 4;
__device__ __forceinline__ void p0_prologue(Frame& F) {
    convert_jobs(F, F.wg, JOB_MOE0, F.G);
    p0_tables(F, 0); p0_tables(F, 1);
    stream_phase(F, F.ka->in.x, wsp<bf16_t>(F, WS_XN), wsp<float>(F, WS_SSQ));
}

__device__ __forceinline__ bf16x8 pack8(const f32x16& v, int base) {
    u32x4 w; w.x = pg8::cvt_pk_bf16(v[base + 0], v[base + 1]); w.y = pg8::cvt_pk_bf16(v[base + 2], v[base + 3]); w.z = pg8::cvt_pk_bf16(v[base + 4], v[base + 5]); w.w = pg8::cvt_pk_bf16(v[base + 6], v[base + 7]);
    return __builtin_bit_cast(bf16x8, w);
}
__device__ __forceinline__ void attn_unit(Frame& F, int layer, int b, int c) {
    const int h = F.wave, lane = F.lane, l31 = lane & 31, hi = lane >> 5;
    LAS float* btab = (LAS float*)(F.lds + TAB_OFF);
    LAS float* red = (LAS float*)(F.lds + TAB_OFF + 8448);
    const float* rb = F.ka->in.rel_bias + (size_t)layer * NHEAD * 257;
    for (int i = F.tid; i < NHEAD * 257; i += 512) { const int hh = i / 257, j = i - hh * 257; btab[hh * 260 + j] = rb[i] * LOG2E; }
    LDS_WAIT(); __syncthreads();
    const bf16_t* Qb = wsp<bf16_t>(F, WS_QK); const bf16_t* KC = wsp<bf16_t>(F, WS_KC); const bf16_t* VC = wsp<bf16_t>(F, WS_VT); bf16_t* MIX = wsp<bf16_t>(F, WS_MIX);
    const size_t tok0 = (size_t)b * SEQ + c * CHUNK;
    const LAS float* bt = btab + h * 260;
    LAS unsigned char* Kl = F.lds + h * 16384; LAS unsigned char* Vl = Kl + 8192;
    const unsigned cce = (unsigned)((lane & 7) ^ (lane >> 4)), cco = cce ^ 4u;
    const unsigned kl = (unsigned)(32 * (lane >> 5) + ((lane >> 3) & 3)) * 128u, vl = (unsigned)(lane >> 3) * 128u;
    unsigned ko[2], vo[2]; ko[0] = kl + 16u * cce; ko[1] = kl + 16u * cco; vo[0] = vl + 16u * cce; vo[1] = vl + 16u * cco;
    const char* Kg = (const char*)(KC + ((size_t)(b * NCH) * NHEAD + h) * 4096);
    const char* Vg = (const char*)(VC + ((size_t)(b * NCH) * NHEAD + h) * 4096);
    const unsigned kbase = (unsigned)__builtin_amdgcn_readfirstlane((int)(h * 16384)), vbase = kbase + 8192u;
    const __amdgpu_buffer_rsrc_t rW = __builtin_amdgcn_make_buffer_rsrc((void*)F.ws, 0, 0x7fffffff, 0x00020000);
    const unsigned kgo = (unsigned)__builtin_amdgcn_readfirstlane((int)(unsigned)(Kg - (const char*)F.ws)), vgo = (unsigned)__builtin_amdgcn_readfirstlane((int)(unsigned)(Vg - (const char*)F.ws));
#define ATT_DMA_K(cb_) do { const unsigned g_ = kgo + (unsigned)(c - 8 + (cb_)) * 65536u; _Pragma("unroll") for (int G = 0; G < 8; ++G) \
        __builtin_amdgcn_raw_ptr_buffer_load_lds(rW, (LAS void*)(F.lds + kbase + G * 1024), 16, (int)ko[G & 1], (int)(g_ + (unsigned)((16 * (G >> 2) + 4 * (G & 3)) * 128)), 0, 0); } while (0)
#define ATT_DMA_V(cb_) do { const unsigned g_ = vgo + (unsigned)(c - 8 + (cb_)) * 65536u; _Pragma("unroll") for (int G = 0; G < 8; ++G) \
        __builtin_amdgcn_raw_ptr_buffer_load_lds(rW, (LAS void*)(F.lds + vbase + G * 1024), 16, (int)vo[G & 1], (int)(g_ + (unsigned)(G * 1024)), 0, 0); } while (0)
    const int cbs = (c >= 8 ? 0 : 8 - c);
    const int swz = (l31 >> 1) & 7;
    const LAS unsigned char* krd = Kl + l31 * 128; const LAS unsigned char* vrd = Vl + l31 * 128;
    const float* gg = F.ka->in.g_group + (size_t)layer * D + h * HD;
    ATT_DMA_K(cbs); ATT_DMA_V(cbs);
    bf16x8 qf0[4];
    const bf16_t* q1p = Qb + (tok0 + 32 + l31) * 512 + h * HD + 32 * hi;
#pragma unroll
    for (int ks = 0; ks < 4; ++ks) qf0[ks] = *(const bf16x8*)(Qb + (tok0 + l31) * 512 + h * HD + 32 * hi + 8 * ks);
#pragma unroll
    for (int ks = 0; ks < 4; ++ks) asm volatile("" : "+v"(qf0[ks]));
    f32x16 o[2][2];
#pragma unroll
    for (int qt = 0; qt < 2; ++qt)
#pragma unroll
        for (int dt = 0; dt < 2; ++dt)
#pragma unroll
            for (int r = 0; r < 16; ++r) o[qt][dt][r] = 0.f;
    float mrun[2] = {-1e30f, -1e30f}, lrun[2] = {0.f, 0.f};
#pragma unroll 1
    for (int cb = cbs; cb <= 8; ++cb) {
        asm volatile("s_waitcnt vmcnt(8)" ::: "memory");
        bf16x8 kf[2][4];
#pragma unroll
        for (int t2 = 0; t2 < 2; ++t2)
#pragma unroll
            for (int ks = 0; ks < 4; ++ks) kf[t2][ks] = *(const LAS bf16x8*)(krd + t2 * 4096 + 16 * ((4 * hi + ks) ^ swz));
        bf16x8 q1[4];
#pragma unroll
        for (int ks = 0; ks < 4; ++ks) q1[ks] = *(const bf16x8*)(q1p + 8 * ks);
        asm volatile("s_waitcnt lgkmcnt(0)" ::: "memory");
        ATT_DMA_K(cb < 8 ? cb + 1 : 8);
        asm volatile("" ::: "memory");
        bf16x8 pf[2][4];
#pragma unroll
        for (int qt = 0; qt < 2; ++qt) {
            f32x16 s0, s1;
#pragma unroll
            for (int r = 0; r < 16; ++r) { s0[r] = 0.f; s1[r] = 0.f; }
#pragma unroll
            for (int ks = 0; ks < 4; ++ks) { const bf16x8 qq = qt ? q1[ks] : qf0[ks]; s0 = __builtin_amdgcn_mfma_f32_32x32x16_bf16(kf[0][ks], qq, s0, 0, 0, 0); s1 = __builtin_amdgcn_mfma_f32_32x32x16_bf16(kf[1][ks], qq, s1, 0, 0, 0); }
            float mx = -1e30f;
            if (cb <= 5) { const float cbias = bt[256];
#pragma unroll
                for (int r = 0; r < 16; ++r) { s0[r] += cbias; s1[r] += cbias; mx = fmaxf(mx, fmaxf(s0[r], s1[r])); }
            } else { const int rb0 = (8 - cb) * CHUNK + 32 * qt + l31 - 32 * hi;
#pragma unroll
                for (int r = 0; r < 16; ++r) { int i0 = rb0 - r; i0 = (i0 > 128 ? 128 : i0) + 128; int i1 = rb0 - 16 - r; i1 = (i1 > 128 ? 128 : i1) + 128;
                    s0[r] += bt[i0]; s1[r] += bt[i1]; mx = fmaxf(mx, fmaxf(s0[r], s1[r])); } }
            mx = fmaxf(mx, shx(mx, 32));
            const float mnew = fmaxf(mrun[qt], mx), alpha = fexp2(mrun[qt] - mnew); mrun[qt] = mnew;
            float ps = 0.f;
#pragma unroll
            for (int r = 0; r < 16; ++r) { s0[r] = fexp2(s0[r] - mnew); s1[r] = fexp2(s1[r] - mnew); ps += s0[r] + s1[r]; }
            lrun[qt] = lrun[qt] * alpha + ps;
#pragma unroll
            for (int r = 0; r < 16; ++r) { o[qt][0][r] *= alpha; o[qt][1][r] *= alpha; }
            pf[qt][0] = pack8(s0, 0); pf[qt][1] = pack8(s0, 8); pf[qt][2] = pack8(s1, 0); pf[qt][3] = pack8(s1, 8);
        }
        asm volatile("s_waitcnt vmcnt(8)" ::: "memory");
#pragma unroll
        for (int dt = 0; dt < 2; ++dt) {
            bf16x8 vf[4];
#pragma unroll
            for (int j = 0; j < 4; ++j) vf[j] = *(const LAS bf16x8*)(vrd + dt * 4096 + 16 * ((4 * hi + j) ^ swz));
#pragma unroll
            for (int j = 0; j < 4; ++j) { o[0][dt] = __builtin_amdgcn_mfma_f32_32x32x16_bf16(vf[j], pf[0][j], o[0][dt], 0, 0, 0); o[1][dt] = __builtin_amdgcn_mfma_f32_32x32x16_bf16(vf[j], pf[1][j], o[1][dt], 0, 0, 0); }
        }
        asm volatile("s_waitcnt lgkmcnt(0)" ::: "memory");
        ATT_DMA_V(cb < 8 ? cb + 1 : 8);
        asm volatile("" ::: "memory");
    }
#undef ATT_DMA_K
#undef ATT_DMA_V
#pragma unroll
    for (int qt = 0; qt < 2; ++qt) {
        const float lt = lrun[qt] + shx(lrun[qt], 32), inv = 1.0f / lt; float ss = 0.f;
#pragma unroll
        for (int dt = 0; dt < 2; ++dt)
#pragma unroll
            for (int r = 0; r < 16; ++r) { o[qt][dt][r] *= inv; ss += o[qt][dt][r] * o[qt][dt][r]; }
        ss += shx(ss, 32);
        if (hi == 0) red[h * 64 + 32 * qt + l31] = ss;
    }
    LDS_WAIT(); __syncthreads();
#pragma unroll
    for (int qt = 0; qt < 2; ++qt) {
        float tot = 0.f;
#pragma unroll
        for (int hh = 0; hh < NHEAD; ++hh) tot += red[hh * 64 + 32 * qt + l31];
        const float rstd = 1.0f / sqrtf(tot * (1.0f / D_ATTN) + EPS);
        bf16_t* orow = MIX + (tok0 + 32 * qt + l31) * 1024 + h * HD;
#pragma unroll
        for (int dt = 0; dt < 2; ++dt)
#pragma unroll
            for (int g4 = 0; g4 < 4; ++g4) { const int d0 = 32 * dt + 8 * g4 + 4 * hi; const f32x4 gv = *(const f32x4*)(gg + d0);
                u32x2 w; w.x = pg8::cvt_pk_bf16(o[qt][dt][4 * g4 + 0] * rstd * gv[0], o[qt][dt][4 * g4 + 1] * rstd * gv[1]); w.y = pg8::cvt_pk_bf16(o[qt][dt][4 * g4 + 2] * rstd * gv[2], o[qt][dt][4 * g4 + 3] * rstd * gv[3]);
                *(u32x2*)(orow + d0) = w; }
    }
    VM_WAIT(); __syncthreads();
}

constexpr int XCB_PITCH = 264;
__device__ __forceinline__ void rg1_unit(Frame& F, int layer, int b, int c) {
    const int tid = F.tid, lane = F.lane, l31 = lane & 31, hi = lane >> 5, w = F.wave;
    LAS float* XC = (LAS float*)F.lds;
    LAS bf16_t* XCB = (LAS bf16_t*)(F.lds + 65536);
    const bf16_t* RGS = wsp<bf16_t>(F, WS_RGS);
    const size_t tok0 = (size_t)b * SEQ + c * CHUNK;
    { const int ch = tid & 255, th = tid >> 8; const int tl0 = c * CHUNK + 32 * th;
        const float* cw = F.ka->in.rg_conv_w + (size_t)layer * 4 * D_RG; const float w0 = cw[ch], w1 = cw[D_RG + ch], w2 = cw[2 * D_RG + ch], w3 = cw[3 * D_RG + ch], cbv = F.ka->in.rg_conv_b[layer * D_RG + ch];
        const bf16_t* xp = RGS + ((size_t)b * SEQ + tl0) * 768 + ch;
        float xm3 = tl0 >= 3 ? bf2f(xp[-3 * 768]) : 0.f, xm2 = tl0 >= 2 ? bf2f(xp[-2 * 768]) : 0.f, xm1 = tl0 >= 1 ? bf2f(xp[-1 * 768]) : 0.f;
#pragma unroll 8
        for (int i = 0; i < 32; ++i) { const float x0 = bf2f(xp[(size_t)i * 768]); const float xc = w0 * xm3 + w1 * xm2 + w2 * xm1 + w3 * x0 + cbv;
            XC[(32 * th + i) * 256 + ch] = xc; XCB[(32 * th + i) * XCB_PITCH + ch] = (bf16_t)f2bf(xc); xm3 = xm2; xm2 = xm1; xm1 = x0; } }
    LDS_WAIT(); __syncthreads();
    const int hb = w >> 1, nt = w & 1, chn = hb * 64 + nt * 32 + l31;
    const unsigned char* tb = F.ws + WS_TAB + layer * TAB_L;
    const bf16_t* WXT = (const bf16_t*)(tb + TB_RGWX) + (size_t)(hb * 64 + nt * 32 + l31) * 64; const bf16_t* WAT = (const bf16_t*)(tb + TB_RGWA) + (size_t)(hb * 64 + nt * 32 + l31) * 64;
    const int trow = 16 * ((l31 >> 2) & 1) + 4 * (l31 >> 3) + (l31 & 3);
    f32x16 gxa[2], gaa[2];
#pragma unroll
    for (int tt = 0; tt < 2; ++tt)
#pragma unroll
        for (int r = 0; r < 16; ++r) { gxa[tt][r] = 0.f; gaa[tt][r] = 0.f; }
#pragma unroll
    for (int ks = 0; ks < 4; ++ks) { const bf16x8 bx = *(const bf16x8*)(WXT + 16 * ks + 8 * hi), ba = *(const bf16x8*)(WAT + 16 * ks + 8 * hi);
#pragma unroll
        for (int tt = 0; tt < 2; ++tt) { const bf16x8 a = *(const LAS bf16x8*)(XCB + (32 * tt + trow) * XCB_PITCH + hb * 64 + 16 * ks + 8 * hi);
            gxa[tt] = __builtin_amdgcn_mfma_f32_32x32x16_bf16(a, bx, gxa[tt], 0, 0, 0); gaa[tt] = __builtin_amdgcn_mfma_f32_32x32x16_bf16(a, ba, gaa[tt], 0, 0, 0); } }
    const float bxv = F.ka->in.rg_bx[layer * D_RG + chn], bav = F.ka->in.rg_ba[layer * D_RG + chn], lam = F.ka->in.rg_lambda[layer * D_RG + chn];
    const float c8 = -8.0f * log1pf(expf(-lam));
#pragma unroll
    for (int tt = 0; tt < 2; ++tt) { float P = 1.f, H = 0.f;
#pragma unroll
        for (int r = 0; r < 16; ++r) { const float xv = XC[(32 * tt + 16 * hi + r) * 256 + chn];
            const float gx = sigmoidf_(gxa[tt][r] + bxv), ga = sigmoidf_(gaa[tt][r] + bav);
            const float la = c8 * ga, x2 = 2.0f * la;
            const float a = 1.0f + la * (1.0f + la * (0.5f + la * (0.16666667f + la * (0.041666668f + la * 0.0083333338f))));
            const float mult = sqrtf(-x2 * (1.0f + x2 * (0.5f + x2 * (0.16666667f + x2 * (0.041666668f + x2 * 0.0083333338f)))));
            H = a * H + mult * gx * xv; P = a * P; gxa[tt][r] = H; gaa[tt][r] = P; } }
    float oP[2], oH[2];
#pragma unroll
    for (int tt = 0; tt < 2; ++tt) { oP[tt] = shx(gaa[tt][15], 32); oH[tt] = shx(gxa[tt][15], 32); }
    const float P0 = hi ? oP[0] : gaa[0][15], H0 = hi ? oH[0] : gxa[0][15], P1 = hi ? gaa[0][15] : oP[0], H1 = hi ? gxa[0][15] : oH[0];
    const float P2 = hi ? oP[1] : gaa[1][15], H2 = hi ? oH[1] : gxa[1][15], P3 = hi ? gaa[1][15] : oP[1], H3 = hi ? gxa[1][15] : oH[1];
    const float Pc2 = P0 * P1, Hc2 = P1 * H0 + H1, Pc3 = Pc2 * P2, Hc3 = P2 * Hc2 + H2, Pt = Pc3 * P3, Ht = P3 * Hc3 + H3;
    float Pc[2], Hc[2]; Pc[0] = hi ? P0 : 1.f; Hc[0] = hi ? H0 : 0.f; Pc[1] = hi ? Pc3 : Pc2; Hc[1] = hi ? Hc3 : Hc2;
    float* RGH = wsp<float>(F, WS_RGH); float* RGA = wsp<float>(F, WS_RGA);
#pragma unroll
    for (int tt = 0; tt < 2; ++tt)
#pragma unroll
        for (int r = 0; r < 16; ++r) { const size_t o = (tok0 + 32 * tt + 16 * hi + r) * 256 + chn; RGA[o] = Pc[tt] * gaa[tt][r]; RGH[o] = gaa[tt][r] * Hc[tt] + gxa[tt][r]; }
    if (hi == 0) { wsp<float>(F, WS_RGCP)[(size_t)(b * NCH + c) * 256 + chn] = Pt; wsp<float>(F, WS_RGCH)[(size_t)(b * NCH + c) * 256 + chn] = Ht; }
    __syncthreads();
}
__device__ __forceinline__ void rg3_unit(Frame& F, int layer, int b, int c) {
    const int tid = F.tid, ch = tid & 255, th = tid >> 8;
    LAS float* red = (LAS float*)F.lds;
    const float* CP = wsp<float>(F, WS_RGCP) + (size_t)b * NCH * 256 + ch; const float* CH = wsp<float>(F, WS_RGCH) + (size_t)b * NCH * 256 + ch;
    float Hs = 0.f;
    for (int j0 = 0; j0 < c; j0 += 16) { float cp[16], chv[16];
#pragma unroll
        for (int j = 0; j < 16; ++j) { const int jj = (j0 + j < c) ? j0 + j : c - 1; cp[j] = CP[jj * 256]; chv[j] = CH[jj * 256]; }
#pragma unroll
        for (int j = 0; j < 16; ++j) if (j0 + j < c) Hs = cp[j] * Hs + chv[j]; }
    const size_t tok0 = (size_t)b * SEQ + c * CHUNK + 32 * th;
    const float* RGH = wsp<float>(F, WS_RGH) + tok0 * 256 + ch; const float* RGA = wsp<float>(F, WS_RGA) + tok0 * 256 + ch; const bf16_t* GATE = wsp<bf16_t>(F, WS_RGS) + tok0 * 768 + 256 + ch;
    float y[32];
#pragma unroll
    for (int i = 0; i < 32; ++i) { const float hv = RGH[i * 256] + RGA[i * 256] * Hs; y[i] = hv * gelu_tanh(bf2f(GATE[(size_t)i * 768])); }
#pragma unroll
    for (int i = 0; i < 32; ++i) { const float s = wave_sum(y[i] * y[i]); if (F.lane == 0) red[(32 * th + i) * 4 + (F.wave & 3)] = s; }
    LDS_WAIT(); __syncthreads();
    const float gv = F.ka->in.g_group[(size_t)layer * D + 512 + ch];
    bf16_t* MIX = wsp<bf16_t>(F, WS_MIX) + tok0 * 1024 + 512 + ch;
#pragma unroll
    for (int i = 0; i < 32; ++i) { const f32x4 p = *(const LAS f32x4*)(red + (32 * th + i) * 4); const float rstd = 1.0f / sqrtf(((p[0] + p[1]) + (p[2] + p[3])) * (1.0f / D_RG) + EPS);
        MIX[(size_t)i * 1024] = (bf16_t)f2bf(y[i] * rstd * gv); }
    __syncthreads();
}

__device__ __forceinline__ void s5_stage_a(Frame& F, int g, int mt, LAS unsigned char* AP) {
    const int b = mt >> 1, c0 = 32 * (mt & 1);
    const bf16_t* US = wsp<bf16_t>(F, WS_RGS) + ((size_t)b * SEQ + c0 * CHUNK) * 768 + 512 + g * 16;
    u32x4 v[8];
#pragma unroll
    for (int j = 0; j < 8; ++j) { const int p = F.tid + 512 * j, hi = p & 1, sx = (p >> 1) & 63, i = p >> 7; v[j] = *(const u32x4*)(US + (size_t)(i * CHUNK + sx) * 768 + 8 * hi); }
#pragma unroll
    for (int j = 0; j < 8; ++j) { const int p = F.tid + 512 * j, hi = p & 1, sx = (p >> 1) & 63, i = p >> 7; *(LAS u32x4*)(AP + sx * 1024 + hi * 512 + i * 16) = v[j]; }
}
__device__ __forceinline__ void s5loc_unit(Frame& F, int layer, int g, int mt) {
    const int lane = F.lane, l31 = lane & 31, hi = lane >> 5, w = F.wave, ntile = w & 3, sh = w >> 2;
    LAS unsigned char* AP = F.lds;
    LAS float* xch = (LAS float*)(F.lds + 65536);
    const unsigned char* tb = F.ws + WS_TAB + layer * TAB_L;
    const bf16_t* WIN = (const bf16_t*)(tb + TB_WIN) + (size_t)(g * 128 + 32 * ntile + l31) * 1024 + 8 * hi + 32 * sh * 16;
    bf16x8 bb[32];
#pragma unroll
    for (int s = 0; s < 32; ++s) bb[s] = *(const bf16x8*)(WIN + s * 16);
    s5_stage_a(F, g, mt, AP);
    LDS_WAIT(); __syncthreads();
    f32x16 acc;
#pragma unroll
    for (int r = 0; r < 16; ++r) acc[r] = 0.f;
    const LAS unsigned char* ard = AP + (32 * sh) * 1024 + hi * 512 + l31 * 16;
#pragma unroll
    for (int s = 0; s < 32; ++s) { const bf16x8 a = *(const LAS bf16x8*)(ard + s * 1024); acc = __builtin_amdgcn_mfma_f32_32x32x16_bf16(a, bb[s], acc, 0, 0, 0); }
    if (sh == 1) {
#pragma unroll
        for (int r = 0; r < 16; ++r) xch[(ntile * 64 + lane) * 16 + r] = acc[r]; }
    LDS_WAIT(); __syncthreads();
    if (sh == 0) { float* SL = wsp<float>(F, WS_SLOC);
#pragma unroll
        for (int r = 0; r < 16; ++r) { const int row = (r & 3) + 8 * (r >> 2) + 4 * hi; SL[((size_t)(32 * mt + row) * S5G + g) * 128 + 32 * ntile + l31] = acc[r] + xch[(ntile * 64 + lane) * 16 + r]; } }
    __syncthreads();
}
constexpr int HS_PITCH = 136;
constexpr int S5Y_KM = 65536, S5Y_HS = S5Y_KM + 33280, S5Y_SLL = S5Y_HS + 8704;
static_assert(S5Y_SLL + 32768 <= MISC_OFF, "s5y LDS map");
__device__ __forceinline__ void s5y_unit(Frame& F, int layer, int g, int mt, int h2) {
    const int lane = F.lane, l31 = lane & 31, hi = lane >> 5, w = F.wave;
    LAS unsigned char* AP = F.lds;
    LAS unsigned char* KM = F.lds + S5Y_KM;
    LAS bf16_t* HS = (LAS bf16_t*)(F.lds + S5Y_HS);
    LAS float* SLL = (LAS float*)(F.lds + S5Y_SLL);
    const unsigned char* tb = F.ws + WS_TAB + layer * TAB_L;
    const int b = mt >> 1, c0 = 32 * (mt & 1), nchunk = c0 + 31;
    int jn[2]; jn[0] = 8 * h2 + w; jn[1] = 31 - jn[0];
    const bf16_t* WOUT = (const bf16_t*)(tb + TB_WOUT) + (size_t)g * 1024 * 128 + 8 * hi;
    bf16x8 wo[2][8];
#pragma unroll
    for (int q = 0; q < 2; ++q)
#pragma unroll
        for (int ks = 0; ks < 8; ++ks) wo[q][ks] = *(const bf16x8*)(WOUT + (size_t)(32 * jn[q] + l31) * 128 + 16 * ks);
    { const float* SL = wsp<float>(F, WS_SLOC) + ((size_t)(b * NCH) * S5G + g) * 128;
      f32x4 sv[4];
#pragma unroll
      for (int j = 0; j < 4; ++j) { const int idx = F.tid + 512 * j, cc = idx >> 5, q4 = idx & 31; sv[j] = (cc < nchunk) ? *(const f32x4*)(SL + (size_t)cc * S5G * 128 + 4 * q4) : (f32x4){0.f, 0.f, 0.f, 0.f}; }
      const bf16_t* KG = (const bf16_t*)(tb + TB_KMAT) + (size_t)g * 65 * 256;
      u32x4 kv[5];
#pragma unroll
      for (int j = 0; j < 5; ++j) { const int p = F.tid + 512 * j; kv[j] = (p < 65 * 32) ? *(const u32x4*)(KG + (size_t)p * 8) : (u32x4){0u, 0u, 0u, 0u}; }
      s5_stage_a(F, g, mt, AP);
#pragma unroll
      for (int j = 0; j < 4; ++j) { const int idx = F.tid + 512 * j, cc = idx >> 5, q4 = idx & 31; *(LAS f32x4*)(SLL + cc * 128 + 4 * q4) = sv[j]; }
#pragma unroll
      for (int j = 0; j < 5; ++j) { const int p = F.tid + 512 * j; if (p < 65 * 32) { const int li = p >> 5, co = (p >> 1) & 15, kh = p & 1; *(LAS u32x4*)(KM + li * 512 + kh * 256 + co * 16) = kv[j]; } }
    }
    LDS_WAIT(); __syncthreads();
    if (w == 0) { const float* APT = (const float*)(tb + TB_APT) + (g * S5P + lane) * 2; const float ar = APT[0], ai = APT[1];
        float hr = 0.f, hm = 0.f;
#pragma unroll 8
        for (int cc = 0; cc < c0 + 32; ++cc) {
            if (cc >= c0) { HS[(cc - c0) * HS_PITCH + lane] = (bf16_t)f2bf(hr); HS[(cc - c0) * HS_PITCH + 64 + lane] = (bf16_t)f2bf(hm); }
            const float sr = SLL[cc * 128 + lane], si = SLL[cc * 128 + 64 + lane];
            const float nr = ar * hr - ai * hm + sr, ni = ar * hm + ai * hr + si; hr = nr; hm = ni; } }
    LDS_WAIT(); __syncthreads();
    const int tl = l31 >> 4, co = l31 & 15;
    f32x16 acc[2];
#pragma unroll
    for (int q = 0; q < 2; ++q)
#pragma unroll
        for (int r = 0; r < 16; ++r) acc[q][r] = 0.f;
    const int smax = 2 * jn[1] + 1;
    const LAS unsigned char* ard = AP + hi * 512 + l31 * 16;
    const LAS unsigned char* krd = KM + hi * 256 + co * 16;
#pragma unroll 4
    for (int s = 0; s <= smax; ++s) { const bf16x8 a = *(const LAS bf16x8*)(ard + s * 1024);
#pragma unroll
        for (int q = 0; q < 2; ++q) if (s <= 2 * jn[q] + 1) { const int li = 2 * jn[q] + tl - s + 1; const bf16x8 bb = *(const LAS bf16x8*)(krd + li * 512);
            acc[q] = __builtin_amdgcn_mfma_f32_32x32x16_bf16(a, bb, acc[q], 0, 0, 0); } }
#pragma unroll
    for (int ks = 0; ks < 8; ++ks) { const bf16x8 a = *(const LAS bf16x8*)(HS + l31 * HS_PITCH + 16 * ks + 8 * hi);
#pragma unroll
        for (int q = 0; q < 2; ++q) acc[q] = __builtin_amdgcn_mfma_f32_32x32x16_bf16(a, wo[q][ks], acc[q], 0, 0, 0); }
    const int ch = g * 16 + co; const float dv = F.ka->in.s5_d[layer * D_S5 + ch];
    bf16_t* S5Y = wsp<bf16_t>(F, WS_S5Y);
    const LAS bf16_t* AP16 = (const LAS bf16_t*)AP;
#pragma unroll
    for (int q = 0; q < 2; ++q)
#pragma unroll
        for (int r = 0; r < 16; ++r) { const int row = (r & 3) + 8 * (r >> 2) + 4 * hi, t = 2 * jn[q] + tl; const size_t tok = (size_t)b * SEQ + (c0 + row) * CHUNK + t;
            const float uv = bf2f(AP16[t * 512 + (co >> 3) * 256 + row * 8 + (co & 7)]); S5Y[tok * 256 + ch] = (bf16_t)f2bf(gelu_tanh(acc[q][r] + dv * uv)); }
    __syncthreads();
}

__device__ __forceinline__ void r1_phase(Frame& F) {
    LAS float* rt = (LAS float*)F.lds;
    LAS int* cnt = (LAS int*)(F.lds + 32768);
    for (int i = F.tid; i < NE * D; i += 512) { const int e = i >> 10, k = i & 1023; rt[i] = F.ka->in.moe_router[k * NE + e]; }
    if (F.tid < NE) cnt[F.tid] = 0;
    LDS_WAIT(); __syncthreads();
    const int TPW = M / F.G, per_wave = TPW / NWAVES;
    const bf16_t* XS = wsp<bf16_t>(F, WS_XN); bf16_t* XNM = wsp<bf16_t>(F, WS_XNM); unsigned* TI = wsp<unsigned>(F, WS_TOKINFO);
    const GAS f32x4* gr = (const GAS f32x4*)(F.ka->in.norm_ffn_g + D) + F.lane;
    constexpr int TB = 2;
    for (int t0 = 0; t0 < per_wave; t0 += TB) {
        f32x4 v[TB][4]; float s[TB];
#pragma unroll
        for (int q = 0; q < TB; ++q) { const GAS u32x2* xr = (const GAS u32x2*)(XS + (size_t)(F.wg * TPW + F.wave * per_wave + t0 + q) * D) + F.lane;
#pragma unroll
            for (int j = 0; j < 4; ++j) { const u32x2 w = xr[64 * j]; v[q][j] = (f32x4){bflo(w.x), bfhi(w.x), bflo(w.y), bfhi(w.y)}; } }
#pragma unroll
        for (int q = 0; q < TB; ++q) { float a = 0.f;
#pragma unroll
            for (int j = 0; j < 4; ++j) a += (v[q][j].x * v[q][j].x + v[q][j].y * v[q][j].y) + (v[q][j].z * v[q][j].z + v[q][j].w * v[q][j].w);
            s[q] = a; }
#pragma unroll
        for (int o = 1; o < 64; o <<= 1)
#pragma unroll
            for (int q = 0; q < TB; ++q) s[q] += shx(s[q], o);
#pragma unroll
        for (int q = 0; q < TB; ++q) {
            const int tok = F.wg * TPW + F.wave * per_wave + t0 + q;
            const float rstd = 1.f / sqrtf(s[q] * (1.f / D) + EPS);
            GAS unsigned* o4 = (GAS unsigned*)((unsigned char*)XNM + (size_t)tok * D) + F.lane;
#pragma unroll
            for (int j = 0; j < 4; ++j) { const f32x4 gg = gr[64 * j]; v[q][j].x *= rstd * gg.x; v[q][j].y *= rstd * gg.y; v[q][j].z *= rstd * gg.z; v[q][j].w *= rstd * gg.w;
                o4[64 * j] = pg8::pk4_fp8(v[q][j].x, v[q][j].y, v[q][j].z, v[q][j].w); }
        }
        float lg[TB][NE];
#pragma unroll
        for (int e = 0; e < NE; ++e) {
#pragma unroll
            for (int j = 0; j < 4; ++j) { const f32x4 r = *(const LAS f32x4*)(rt + e * D + 256 * j + 4 * F.lane);
#pragma unroll
                for (int q = 0; q < TB; ++q) { const float a = (v[q][j].x * r.x + v[q][j].y * r.y) + (v[q][j].z * r.z + v[q][j].w * r.w); lg[q][e] = (j == 0) ? a : lg[q][e] + a; } } }
#pragma unroll
        for (int q = 0; q < TB; ++q) {
            const int ln = hw_lane();
            float a4[4], a2[2], a1;
            { const bool up = (ln & 32) != 0;
#pragma unroll
              for (int i = 0; i < 4; ++i) { const float keep = up ? lg[q][4 + i] : lg[q][i], give = up ? lg[q][i] : lg[q][4 + i]; a4[i] = keep + shx(give, 32); } }
            { const bool up = (ln & 16) != 0;
#pragma unroll
              for (int i = 0; i < 2; ++i) { const float keep = up ? a4[2 + i] : a4[i], give = up ? a4[i] : a4[2 + i]; a2[i] = keep + shx(give, 16); } }
            { const bool up = (ln & 8) != 0; const float keep = up ? a2[1] : a2[0], give = up ? a2[0] : a2[1]; a1 = keep + shx(give, 8); }
            a1 += shx(a1, 4); a1 += shx(a1, 2); a1 += shx(a1, 1);
#pragma unroll
            for (int e = 0; e < NE; ++e) lg[q][e] = __builtin_bit_cast(float, __builtin_amdgcn_ds_bpermute((8 * e) << 2, __builtin_bit_cast(int, a1)));
        }
#pragma unroll
        for (int q = 0; q < TB; ++q) {
            const int tok = F.wg * TPW + F.wave * per_wave + t0 + q;
            int i1 = 0; float l1 = lg[q][0];
#pragma unroll
            for (int e = 1; e < NE; ++e) if (lg[q][e] > l1) { l1 = lg[q][e]; i1 = e; }
            int i2 = -1; float l2 = -3.0e38f;
#pragma unroll
            for (int e = 0; e < NE; ++e) if (e != i1 && lg[q][e] > l2) { l2 = lg[q][e]; i2 = e; }
            const float g1 = 1.0f / (1.0f + expf(l2 - l1)), g2 = 1.0f - g1;
            if (F.lane == 0) { *(u32x4*)(TI + (size_t)tok * 4) = (u32x4){(unsigned)i1, (unsigned)i2, __float_as_uint(g1), __float_as_uint(g2)};
                __hip_atomic_fetch_add(&cnt[i1], 1, __ATOMIC_RELAXED, __HIP_MEMORY_SCOPE_WORKGROUP); __hip_atomic_fetch_add(&cnt[i2], 1, __ATOMIC_RELAXED, __HIP_MEMORY_SCOPE_WORKGROUP); }
        }
    }
    LDS_WAIT(); __syncthreads();
    if (F.tid < NE) __hip_atomic_store((unsigned*)F.ctl + CW_CNT + F.wg * NE + F.tid, (unsigned)cnt[F.tid], RLX_AGENT);
    __syncthreads();
}
__device__ __forceinline__ void r2_phase(Frame& F) {
    LAS int* sh = (LAS int*)F.lds;
    { const int e = F.tid & 7, part = (F.tid >> 3) & 7; int tot = 0, mine = 0;
      if (F.tid < 64) { const volatile unsigned* cp_ = (const volatile unsigned*)F.ctl + CW_CNT + e; int cv_[32];
          _Pragma("unroll") for (int q = 0; q < 32; ++q) cv_[q] = (int)((const unsigned*)cp_)[(part * 32 + q) * NE];
          _Pragma("unroll") for (int q = 0; q < 32; ++q) { tot += cv_[q]; if (part * 32 + q < F.wg) mine += cv_[q]; }
          sh[200 + F.tid] = tot; sh[264 + F.tid] = mine; } }
    LDS_WAIT(); __syncthreads();
    if (F.tid < NE) { int tot = 0, mine = 0; for (int part = 0; part < 8; ++part) { tot += sh[200 + part * 8 + F.tid]; mine += sh[264 + part * 8 + F.tid]; } sh[F.tid] = tot; sh[8 + F.tid] = mine; }
    LDS_WAIT(); __syncthreads();
    if (F.tid == 0) { int ps = 0; for (int e = 0; e < NE; ++e) { sh[16 + e] = ps; sh[24 + e] = ps + sh[8 + e]; ps += (sh[e] + 255) & ~255; } sh[160] = ps; }
    LDS_WAIT(); __syncthreads();
    const int TPW = M / F.G, NA = 2 * TPW;
    const unsigned* TI = wsp<unsigned>(F, WS_TOKINFO); int* POS = wsp<int>(F, WS_POS); int* ROWTOK = wsp<int>(F, WS_ROWTOK);
    int e_mine = 0;
    if (F.tid < NA) { e_mine = (int)TI[(size_t)(F.wg * TPW + (F.tid >> 1)) * 4 + (F.tid & 1)]; sh[32 + F.tid] = e_mine; }
    LDS_WAIT(); __syncthreads();
    if (F.tid < NA) { int rank = 0; for (int t = 0; t < F.tid; ++t) rank += (sh[32 + t] == e_mine) ? 1 : 0;
        const int pos = sh[24 + e_mine] + rank; const int tok = F.wg * TPW + (F.tid >> 1);
        POS[tok * 2 + (F.tid & 1)] = pos; ROWTOK[pos] = tok; }
    LDS_WAIT(); __syncthreads();
    if (F.wg == 0) {
        for (int e = 0; e < NE; ++e) { const int ps = sh[16 + e], tot = sh[e], pc = (tot + 255) & ~255;
            for (int p = ps + tot + F.tid; p < ps + pc; p += 512) ROWTOK[p] = 0;
            for (int t = ps / 256 + F.tid; t < (ps + pc) / 256; t += 512) __hip_atomic_store((unsigned*)F.ctl + CW_TILEE + t, (unsigned)e, RLX_AGENT); }
        if (F.tid == 0) __hip_atomic_store((unsigned*)F.ctl + CW_ROUTE + 16, (unsigned)(sh[160] / 256), RLX_AGENT);
    }
    __syncthreads();
}
__device__ __forceinline__ void combine_phase(Frame& F) {
    const int gw = F.wg * NWAVES + F.wave, NGW = F.G * NWAVES;
    const unsigned* TI = wsp<unsigned>(F, WS_TOKINFO); const int* POS = wsp<int>(F, WS_POS); const bf16_t* Y = wsp<bf16_t>(F, WS_YEXP);
    const GAS f32x4* gr = (const GAS f32x4*)F.ka->in.final_norm_g + F.lane;
    for (int tok = gw; tok < M; tok += NGW) {
        const u32x4 ti = *(const u32x4*)(TI + (size_t)tok * 4); const float g1 = __uint_as_float(ti.z), g2 = __uint_as_float(ti.w);
        const int p1 = POS[tok * 2], p2 = POS[tok * 2 + 1];
        GAS f32x4* xr = (GAS f32x4*)(F.out + (size_t)tok * D) + F.lane; const GAS u32x2* xs = (const GAS u32x2*)(wsp<bf16_t>(F, WS_XN) + (size_t)tok * D) + F.lane;
        const GAS u32x2* y1 = (const GAS u32x2*)(Y + (size_t)p1 * D) + F.lane; const GAS u32x2* y2 = (const GAS u32x2*)(Y + (size_t)p2 * D) + F.lane;
        f32x4 v[4]; float s = 0.f;
#pragma unroll
        for (int j = 0; j < 4; ++j) { const u32x2 w = xs[64 * j]; v[j] = (f32x4){bflo(w.x), bfhi(w.x), bflo(w.y), bfhi(w.y)}; const u32x2 a = y1[64 * j], b = y2[64 * j];
            v[j].x += g1 * bflo(a.x) + g2 * bflo(b.x); v[j].y += g1 * bfhi(a.x) + g2 * bfhi(b.x); v[j].z += g1 * bflo(a.y) + g2 * bflo(b.y); v[j].w += g1 * bfhi(a.y) + g2 * bfhi(b.y);
            s += (v[j].x * v[j].x + v[j].y * v[j].y) + (v[j].z * v[j].z + v[j].w * v[j].w); }
        const float rstd = 1.f / sqrtf(wave_sum(s) * (1.f / D) + EPS);
#pragma unroll
        for (int j = 0; j < 4; ++j) { const f32x4 gg = gr[64 * j]; xr[64 * j] = (f32x4){v[j].x * rstd * gg.x, v[j].y * rstd * gg.y, v[j].z * rstd * gg.z, v[j].w * rstd * gg.w}; }
    }
}

constexpr int NPHASE = 20;
#ifndef CODE_PF_BYTES
#define CODE_PF_BYTES 150000
#endif
__device__ __forceinline__ void code_prefetch(const char* pc0, int tid) {
    unsigned acc = 0; int t_ = tid; asm volatile("" : "+v"(t_));
    for (int off = t_ * 128; off < CODE_PF_BYTES; off += 512 * 128) acc += *(const volatile unsigned*)(pc0 + off);
    asm volatile("" :: "v"(acc));
}
typedef const __attribute__((address_space(4))) Args* KArgs;
#define NEWFRAME(F) Frame F; { KArgs ka_ = (KArgs)__builtin_amdgcn_kernarg_segment_ptr(); asm volatile("" : "+s"(ka_)); int wv_ = wave0_; asm volatile("" : "+s"(wv_)); int t_ = wv_ * 64 + hw_lane(); asm volatile("" : "+v"(t_)); \
    F.ka = ka_; F.lds = (LAS unsigned char*)lds_raw; F.ws = ka_->ws; F.ctl = (gu32*)(ka_->ws + WS_CTL); F.out = ka_->out; \
    F.tid = t_; F.lane = t_ & 63; F.wave = __builtin_amdgcn_readfirstlane(t_ >> 6); { int g_ = gridDim.x, w_ = blockIdx.x; { const unsigned vw_ = ((volatile LAS unsigned*)((LAS unsigned char*)lds_raw + MISC_OFF))[21]; if (vw_) w_ = __builtin_amdgcn_readfirstlane((int)vw_ - 1); } asm volatile("" : "+s"(g_), "+s"(w_)); F.G = g_; F.wg = w_; } }
__global__ void __launch_bounds__(NWAVES * 64, 2) fwd(Args args) {
    extern __shared__ __attribute__((aligned(16))) unsigned char lds_raw[];
    const char* pc0_ = (const char*)(((unsigned long long)__builtin_amdgcn_s_getpc()) & ~255ull);
    volatile LAS unsigned* MISC = (volatile LAS unsigned*)((LAS unsigned char*)lds_raw + MISC_OFF);
    const int wave0_ = __builtin_amdgcn_readfirstlane((int)threadIdx.x >> 6);
    { const int t0_ = wave0_ * 64 + hw_lane(); if (t0_ < 32) MISC[t0_] = 0u; }
    __syncthreads();
    if (CODE_PF_BYTES > 0) code_prefetch(pc0_, wave0_ * 64 + hw_lane());
    if (wave0_ == 0 && hw_lane() == 0) { MISC[16] = (unsigned)(unsigned long long)pc0_; MISC[17] = (unsigned)((unsigned long long)pc0_ >> 32); }
    if (args.ph_hi - args.ph_lo > 1) { (void)xcd_barrier_post((unsigned*)(args.ws + WS_CTL) + CW_BAR, MISC + 8, wave0_ == 0 && hw_lane() == 0); }
    __syncthreads();
#ifndef PHASE_MASK
#define PHASE_MASK 0xFFFFFu
#endif
#ifndef REP_MASK
#define REP_MASK 0x0u
#endif
#ifndef TIME_MASK
#define TIME_MASK 0x0u
#endif
#ifndef SUBREP_MASK
#define SUBREP_MASK 0u
#endif
#ifndef SUBTIME_MASK
#define SUBTIME_MASK 0x0u
#endif
#ifndef MIXA_MASK
#define MIXA_MASK 7
#endif
#ifndef SEAM_REPS
#define SEAM_REPS 1
#endif
#define TABP ((LAS int*)(F.lds + TAB_OFF))
#define SUBREP(k) for (int sr2_ = 0; sr2_ < 1 + (int)(((SUBREP_MASK) >> (k)) & 1u); ++sr2_)
#define STB(k) do { if (((SUBTIME_MASK) >> (k)) & 1u) tph2_ = __builtin_amdgcn_s_memrealtime(); } while (0)
#define STE(k) do { if (((SUBTIME_MASK) >> (k)) & 1u) { const unsigned long long n_ = __builtin_amdgcn_s_memrealtime(); const unsigned long long until_ = n_ + (n_ - tph2_); \
        while (__builtin_amdgcn_s_memrealtime() < until_) __builtin_amdgcn_s_sleep(8); } } while (0)
#pragma unroll 1
    for (int ph = args.ph_lo; ; ++ph) {
        int hi; { KArgs kh_ = (KArgs)__builtin_amdgcn_kernarg_segment_ptr(); asm volatile("" : "+s"(kh_)); hi = kh_->ph_hi; }
        if (ph >= hi) break;
        unsigned long long tph_ = 0, tph2_ = 0; (void)tph2_;
        const bool timed = (((TIME_MASK) >> ph) & 1u) != 0;
        if (timed) tph_ = __builtin_amdgcn_s_memrealtime();
        const int l = (ph >= 10) ? 1 : 0;
        const int ty = (ph >= 10 && ph <= 14) ? ph - 9 : ph;
        const int nrep = ((((PHASE_MASK) >> ph) & 1u) ? 1 : 0) + (int)(((REP_MASK) >> ph) & 1u);
#pragma unroll 1
        for (int rep_ = 0; rep_ < nrep; ++rep_) {
            switch (ty) {
            case 0: { NEWFRAME(F); p0_prologue(F); } break;
            case 1: {
                NEWFRAME(F);
                pg8::Gemm g{wsp<bf16_t>(F, WS_XN), wsp<bf16_t>(F, WS_WINT + l * WINT_L), D_IN, D, nullptr, nullptr, 0, F.ws, wsp<float>(F, WS_SSQ)};
                pg8::StaticOrder S; S.init(M / 256, D_IN, F.G, F.wg);
                pg8::EpiProj E{wsp<bf16_t>(F, WS_QK), wsp<bf16_t>(F, WS_KC), wsp<bf16_t>(F, WS_VT), wsp<bf16_t>(F, WS_RGS), (const LAS float*)(TABP + 16)};
                pg8::gemm_phase<pg8::EpiProj, true, false>(F.lds, TABP, g, S, E, F.wave);
                { NEWFRAME(F2); if (F2.G == 256 && F2.wg >= 64) { const int j0 = (l ? BG_D0 : BG_A0) + (F2.wg - 64) * 4; convert_jobs(F2, j0, j0 + 4, 1); } }
            } break;
            case 2: {
                NEWFRAME(F);
                const int vcu = (F.G % 8 == 0) ? (F.wg % 8) * (F.G / 8) + F.wg / 8 : F.wg;
                STB(0); if (MIXA_MASK & 1) SUBREP(0) for (int u = vcu; u < NUNIT; u += F.G) attn_unit(F, l, u >> 6, u & 63); STE(0);
                STB(1); if (MIXA_MASK & 2) SUBREP(1) for (int u = F.wg; u < NUNIT; u += F.G) rg1_unit(F, l, u >> 6, u & 63); STE(1);
                STB(2); if (MIXA_MASK & 4) SUBREP(2) for (int u = F.wg; u < S5G * 8; u += F.G) s5loc_unit(F, l, u >> 3, u & 7); STE(2);
                { NEWFRAME(F2); if (F2.G == 256 && F2.wg >= S5G * 8) { const int j0 = JOB_MOE0 + l * (BG_P0 / 2) + (F2.wg - S5G * 8) * 3; convert_jobs(F2, j0, j0 + 3, 1); } }
            } break;
            case 3: {
                NEWFRAME(F);
                STB(3); SUBREP(3) for (int u = F.wg; u < S5G * 16; u += F.G) s5y_unit(F, l, u >> 4, (u >> 1) & 7, u & 1); STE(3);
                STB(4); SUBREP(4) for (int u = F.G - 1 - F.wg; u < NUNIT; u += F.G) rg3_unit(F, l, u >> 6, u & 63); STE(4);
            } break;
            case 4: {
                NEWFRAME(F);
                pg8::StaticOrder S0; S0.init(M / 256, D, F.G, F.wg);
                pg8::Unit u0;
                if (S0.next(0, u0)) {
                    pg8::Gemm g{wsp<bf16_t>(F, WS_S5Y), wsp<bf16_t>(F, WS_TAB + l * TAB_L + TB_WGLU), 256, 256, nullptr, nullptr, 0, F.ws, nullptr};
                    pg8::OneUnit S{u0.pm};
                    pg8::EpiGLU E{wsp<bf16_t>(F, WS_S5Y), wsp<bf16_t>(F, WS_MIX) + 768, F.ka->in.g_group + (size_t)l * D + 768};
                    pg8::gemm_phase<pg8::EpiGLU, false, false>(F.lds, TABP, g, S, E, F.wave);
                }
                VM_WAIT(); __syncthreads();
            } break;
            case 5: case 8: {
                NEWFRAME(F);
                const bool dn = (ty == 8);
                pg8::Gemm g{dn ? wsp<bf16_t>(F, WS_ACT0) : wsp<bf16_t>(F, WS_MIX), dn ? wsp<bf16_t>(F, WS_F2) : wsp<bf16_t>(F, WS_WOUTT + l * WOUTT_L), D, dn ? FF : D, nullptr, nullptr, 0, F.ws, nullptr};
                pg8::StaticOrder S; S.init(M / 256, D, F.G, F.wg);
                pg8::EpiResid E{(!dn && l == 0) ? F.ka->in.x : nullptr, wsp<bf16_t>(F, WS_XN), wsp<bf16_t>(F, WS_XN), wsp<float>(F, WS_SSQ)};
                pg8::gemm_phase<pg8::EpiResid, true, false>(F.lds, TABP, g, S, E, F.wave);
            } break;
            case 7: {
                NEWFRAME(F);
                pg8::Gemm g{wsp<bf16_t>(F, WS_XN), wsp<bf16_t>(F, WS_F13), 2 * FF, D, nullptr, nullptr, 0, F.ws, wsp<float>(F, WS_SSQ)};
                pg8::StaticOrder S; S.init(M / 256, 2 * FF, F.G, F.wg);
                pg8::EpiSwiGLU E{wsp<bf16_t>(F, WS_ACT0), FF, (const LAS float*)(TABP + 16)};
                pg8::gemm_phase<pg8::EpiSwiGLU, true, false>(F.lds, TABP, g, S, E, F.wave);
                { NEWFRAME(F2); if (F2.G == 256 && F2.wg >= 128) { const int j0 = BG_C0 + (F2.wg - 128) * 4; convert_jobs(F2, j0, j0 + 4, 1); } }
            } break;
            case 15: { NEWFRAME(F); r1_phase(F); } break;
            case 16: { NEWFRAME(F); r2_phase(F); } break;
            case 17: {
                NEWFRAME(F);
                const int ntile = (int)__hip_atomic_load((unsigned*)F.ctl + CW_ROUTE + 16, RLX_AGENT);
                pg8::Gemm g{wsp<bf16_t>(F, WS_XNM), wsp<bf16_t>(F, WS_M13), 2 * FF, D, wsp<int>(F, WS_ROWTOK), (const int*)(F.ctl + CW_TILEE), E13, F.ws, nullptr};
                pg8::StaticOrder S; S.init(ntile, 2 * FF, F.G, F.wg);
                pg8::EpiSwiGLU8 E{F.ws + WS_ACT1};
                pg8::gemm_phase<pg8::EpiSwiGLU8, true, true, pg8::StaticOrder, 1>(F.lds, TABP, g, S, E, F.wave);
#ifndef NO_HOOK17
                { NEWFRAME(F2);
                  const int ntile2 = (int)__hip_atomic_load((unsigned*)F2.ctl + CW_ROUTE + 16, RLX_AGENT);
                  const int r = (ntile2 * (2 * FF / 256)) % F2.G, nlate = r ? F2.G - r : 0;
                  int covered = nlate * BG_F_PER; if (covered > JOB_END - JOB_W2) covered = JOB_END - JOB_W2;
                  if (r && F2.wg >= r) { const int j0 = JOB_W2 + (F2.wg - r) * BG_F_PER; int j1 = j0 + BG_F_PER; if (j1 > JOB_END) j1 = JOB_END; if (j0 < JOB_END) convert_jobs(F2, j0, j1, 1); }
                  convert_jobs(F2, JOB_W2 + covered + F2.wg, JOB_END, F2.G); }
#endif
            } break;
            case 18: {
                NEWFRAME(F);
                const int ntile = (int)__hip_atomic_load((unsigned*)F.ctl + CW_ROUTE + 16, RLX_AGENT);
                pg8::Gemm g{wsp<bf16_t>(F, WS_ACT1), wsp<bf16_t>(F, WS_M2), D, FF, nullptr, (const int*)(F.ctl + CW_TILEE), E2, F.ws, nullptr};
                pg8::StaticOrder S; S.init(ntile, D, F.G, F.wg);
                pg8::EpiBf16 E{wsp<bf16_t>(F, WS_YEXP), D};
                pg8::gemm_phase<pg8::EpiBf16, true, false, pg8::StaticOrder, 1>(F.lds, TABP, g, S, E, F.wave);
            } break;
            case 19: { NEWFRAME(F); combine_phase(F); } break;
            default: break;
            }
        }
        if (ph + 1 < hi && ph != 4 && ph != 13 && ph != 6 && ph != 9) {
            if (CODE_PF_BYTES > 0) { volatile LAS unsigned* MI_ = (volatile LAS unsigned*)((LAS unsigned char*)lds_raw + MISC_OFF); int wv2_ = wave0_; asm volatile("" : "+s"(wv2_)); code_prefetch((const char*)(((unsigned long long)MI_[17] << 32) | MI_[16]), wv2_ * 64 + hw_lane()); }
#pragma unroll 1
            for (int sr_ = 0; sr_ < SEAM_REPS; ++sr_) {
                KArgs kb_ = (KArgs)__builtin_amdgcn_kernarg_segment_ptr(); asm volatile("" : "+s"(kb_));
                XcdBarrier bar_; bar_.bar = (unsigned*)(kb_->ws + WS_CTL) + CW_BAR; bar_.x = xb_xcc_id(); bar_.st = (volatile LAS unsigned*)((LAS unsigned char*)lds_raw + MISC_OFF) + 8; { int wv3_ = wave0_; asm volatile("" : "+s"(wv3_)); bar_.leader = (wv3_ == 0 && hw_lane() == 0); } xcd_barrier(bar_); }
        }
        if (timed) { const unsigned long long n_ = __builtin_amdgcn_s_memrealtime(); const unsigned long long until_ = n_ + (n_ - tph_);
            while (__builtin_amdgcn_s_memrealtime() < until_) __builtin_amdgcn_s_sleep(8); }
    }
}

extern "C" void kernel_launch(void* const* d_in, const int* in_sizes, int n_in, void* d_out, int out_size, void* d_ws, size_t ws_size, hipStream_t stream) {
    static int grid = 0;
    if (grid == 0) {
        if (n_in != 31 || in_sizes[0] != M * D || out_size != M * D || ws_size < WS_END) { fprintf(stderr, "kernel_launch: unexpected problem: n_in %d in0 %d out %d ws %zu (need %zu)\n", n_in, n_in > 0 ? in_sizes[0] : -1, out_size, ws_size, (size_t)WS_END); grid = -1; return; }
        int dev = 0, cus = 0, per_cu = 0;
        if (hipGetDevice(&dev) != hipSuccess || hipDeviceGetAttribute(&cus, hipDeviceAttributeMultiprocessorCount, dev) != hipSuccess) { grid = -1; return; }
        if (hipFuncSetAttribute((const void*)fwd, hipFuncAttributeMaxDynamicSharedMemorySize, LDS_BYTES) != hipSuccess) { fprintf(stderr, "kernel_launch: hipFuncSetAttribute failed\n"); grid = -1; return; }
        if (hipOccupancyMaxActiveBlocksPerMultiprocessor(&per_cu, (const void*)fwd, NWAVES * 64, LDS_BYTES) != hipSuccess || per_cu < 1) { fprintf(stderr, "kernel_launch: occupancy query says %d blocks per CU\n", per_cu); grid = -1; (void)hipGetLastError(); return; }
        grid = cus;
        if (grid != 256) { fprintf(stderr, "kernel_launch: built for 256 CUs, found %d\n", cus); grid = -1; return; }
    }
    if (grid < 0) return;
    (void)hipMemsetAsync((char*)d_ws + WS_CTL, 0, CTL_ZERO_BYTES, stream);
    Args a{};
    const float** ip = (const float**)&a.in;
    for (int i = 0; i < 31; ++i) ip[i] = (const float*)d_in[i];
    a.out = (float*)d_out; a.ws = (unsigned char*)d_ws;
#if MK_N_LAUNCHES == 1
    a.ph_lo = 0; a.ph_hi = NPHASE;
    hipLaunchKernelGGL(fwd, dim3(grid), dim3(NWAVES * 64), LDS_BYTES, stream, a);
#else
    for (int p = 0; p < NPHASE; ++p) { a.ph_lo = p; a.ph_hi = p + 1; hipLaunchKernelGGL(fwd, dim3(grid), dim3(NWAVES * 64), LDS_BYTES, stream, a); }
#endif
}
```

```cpp
#include <hip/hip_runtime.h>
#include <cstdio>
#include <cstdint>
#include <cmath>

#ifndef MK_N_LAUNCHES
#define MK_N_LAUNCHES 1
#endif

constexpr int BATCH = 4, SEQ = 4096, D = 1024, M = BATCH * SEQ;
constexpr int DEPTH = 2;
constexpr int CHUNK = 64, NCH = SEQ / CHUNK, NUNIT = BATCH * NCH;
constexpr int D_ATTN = 512, D_RG = 256, D_S5 = 256, D_IN = 2304;
constexpr int NHEAD = 8, HD = 64;
constexpr int FF = 2816, NE = 8;
constexpr int S5G = 16, S5C = 16, S5P = 64;
constexpr float EPS = 1e-6f;
constexpr float LOG2E = 1.4426950408889634f;
constexpr float QSCALE = 0.125f * LOG2E;
constexpr int PMAX = 2 * M + NE * 256;
constexpr int PTILES = PMAX / 256;

#define GAS __attribute__((address_space(1)))
#define LAS __attribute__((address_space(3)))
typedef unsigned short bf16_t;
typedef short bf16x8 __attribute__((ext_vector_type(8)));
typedef float f32x4 __attribute__((ext_vector_type(4)));
typedef float f32x2 __attribute__((ext_vector_type(2)));
typedef float f32x16 __attribute__((ext_vector_type(16)));
typedef unsigned u32x4 __attribute__((ext_vector_type(4)));
typedef unsigned u32x2 __attribute__((ext_vector_type(2)));
typedef GAS unsigned gu32;
#define RLX_AGENT __ATOMIC_RELAXED, __HIP_MEMORY_SCOPE_AGENT
#define LDS_WAIT() asm volatile("s_waitcnt lgkmcnt(0)" ::: "memory")
#define VM_WAIT() asm volatile("s_waitcnt vmcnt(0)" ::: "memory")

__device__ __forceinline__ unsigned f2bf(float f) { unsigned u = __builtin_bit_cast(unsigned, f); return (u + 0x7fffu + ((u >> 16) & 1u)) >> 16; }
__device__ __forceinline__ unsigned pk2(float lo, float hi) { return f2bf(lo) | (f2bf(hi) << 16); }
__device__ __forceinline__ float bf2f(unsigned short h) { return __builtin_bit_cast(float, (unsigned)h << 16); }
__device__ __forceinline__ float bflo(unsigned w) { return __builtin_bit_cast(float, w << 16); }
__device__ __forceinline__ float bfhi(unsigned w) { return __builtin_bit_cast(float, w & 0xffff0000u); }
__device__ __forceinline__ float fexp2(float x) { return __builtin_amdgcn_exp2f(x); }
__device__ __forceinline__ float frcp(float x) { return __builtin_amdgcn_rcpf(x); }
__device__ __forceinline__ float sigmoidf_(float x) { return frcp(1.0f + fexp2(-x * LOG2E)); }
__device__ __forceinline__ float gelu_tanh(float x) {
    const float z = 0.7978845608028654f * (x + 0.044715f * x * x * x);
    return x * frcp(1.0f + fexp2(-2.0f * LOG2E * z));
}
__device__ __forceinline__ int hw_lane() { unsigned m = ~0u; asm volatile("" : "+s"(m)); return (int)__builtin_amdgcn_mbcnt_hi(m, __builtin_amdgcn_mbcnt_lo(m, 0u)); }
__device__ __forceinline__ float shx(float v, int mask) { return __builtin_bit_cast(float, __builtin_amdgcn_ds_bpermute((hw_lane() ^ mask) << 2, __builtin_bit_cast(int, v))); }
__device__ __forceinline__ float wave_sum(float v) {
#pragma unroll
    for (int o = 1; o < 64; o <<= 1) v += shx(v, o);
    return v;
}

namespace pg8 {
#define PG8_LAS __attribute__((address_space(3)))
constexpr int BM = 256, BK = 64, HALF = 128, HTB = HALF * BK * 2  , STAGE_BYTES = 8 * HTB, NXCD = 8, WGM = 8;
constexpr int MAXU = 12;

__host__ __device__ __forceinline__ int lds_byte(int r, int c) { const int st = (r >> 4) * 2 + (c >> 5), rr = r & 15, cc = c & 31, ob = rr * 64 + cc * 2; return st * 1024 + (ob ^ (((ob >> 9) & 1) << 5)); }
__host__ __device__ __forceinline__ void stage_rc(int b, int& R, int& C) { const int st = b / 1024, sb = b % 1024, swz = sb ^ (((sb >> 9) & 1) << 5); R = (st >> 1) * 16 + swz / 64; C = (st & 1) * 32 + (swz % 64) / 2; }
__host__ __device__ __forceinline__ int perm32(int rho) { const int n = rho >> 4, i = rho & 15; return 8 * (i >> 2) + 4 * n + (i & 3); }

struct Unit { int pm, pn, ui; };
struct Gemm { const bf16_t* A; const bf16_t* Bt; int N, K; const int* rowtok; const int* tile_e; size_t estride; const unsigned char* ws; const float* ssq; };

struct StaticOrder {
    int nM, nN, nwg, G, c;
    __host__ __device__ void init(int nM_, int N, int G_, int c_) { nM = nM_; nN = N / BM; nwg = nM * nN; G = G_; c = c_; }
    __host__ __device__ __forceinline__ bool next(int i, Unit& u) const {
        const long L = (long)i * G + c; if (L >= nwg) return false;
        int wgid = (int)L; { const int q = nwg / NXCD, r = nwg % NXCD, xcd = wgid % NXCD, off = wgid / NXCD; wgid = (xcd < r ? xcd * (q + 1) : r * (q + 1) + (xcd - r) * q) + off; }
        const int nig = WGM * nN, gid = wgid / nig, fm = gid * WGM, gsz = (nM - fm) < WGM ? (nM - fm) : WGM;
        u.pm = fm + ((wgid % nig) % gsz); u.pn = (wgid % nig) / gsz; return true;
    }
};

__device__ __forceinline__ unsigned cvt_pk_bf16(float lo, float hi) { unsigned r; asm volatile("v_cvt_pk_bf16_f32 %0, %1, %2" : "=v"(r) : "v"(lo), "v"(hi)); return r; }


struct EpiProj {
    static constexpr bool PERM = true, AFTER_DRAIN = false;
    bf16_t* Q; bf16_t* KC; bf16_t* VC; bf16_t* RGS; const PG8_LAS float* rs;
    __device__ __forceinline__ void operator()(const f32x4 (&acc)[2][2][4][2], const Unit& u, int wr, int wc, int fr, int fq) const {
        const int row0 = u.pm * BM + wr * 64 + fr;
        float rsv[2][4];
#pragma unroll
        for (int ai = 0; ai < 2; ++ai)
#pragma unroll
            for (int m = 0; m < 4; ++m) rsv[ai][m] = rs[256 * u.ui + wr * 64 + fr + ai * HALF + m * 16];
        if (u.pn < 2 || u.pn >= 6) {
            bf16_t* base; int ldc, colt; float sc = 1.f;
            if (u.pn < 2) { base = Q; ldc = 512; colt = u.pn * BM; sc = QSCALE; } else { base = RGS; ldc = 768; colt = (u.pn - 6) * BM; }
            const int col0 = colt + wc * 32 + 8 * fq;
#pragma unroll
            for (int ai = 0; ai < 2; ++ai)
#pragma unroll
                for (int m = 0; m < 4; ++m) { bf16_t* rowp = base + (size_t)(row0 + ai * HALF + m * 16) * ldc + col0;
#pragma unroll
                    for (int bj = 0; bj < 2; ++bj) { const float sr = sc * rsv[ai][m]; const f32x4 v0 = acc[ai][bj][m][0] * sr, v1 = acc[ai][bj][m][1] * sr;
                        u32x4 w; w.x = cvt_pk_bf16(v0[0], v0[1]); w.y = cvt_pk_bf16(v0[2], v0[3]); w.z = cvt_pk_bf16(v1[0], v1[1]); w.w = cvt_pk_bf16(v1[2], v1[3]);
                        *(u32x4*)(rowp + bj * HALF) = w; } }
        } else if (u.pn < 4) {
            const int ck0 = (u.pn - 2) * BM + wc * 32 + 8 * fq;
#pragma unroll
            for (int ai = 0; ai < 2; ++ai)
#pragma unroll
                for (int m = 0; m < 4; ++m) { const int r = row0 + ai * HALF + m * 16;
#pragma unroll
                    for (int bj = 0; bj < 2; ++bj) { const int ck = ck0 + bj * HALF; const f32x4 v0 = acc[ai][bj][m][0] * rsv[ai][m], v1 = acc[ai][bj][m][1] * rsv[ai][m];
                        u32x4 w; w.x = cvt_pk_bf16(v0[0], v0[1]); w.y = cvt_pk_bf16(v0[2], v0[3]); w.z = cvt_pk_bf16(v1[0], v1[1]); w.w = cvt_pk_bf16(v1[2], v1[3]);
                        *(u32x4*)(KC + ((size_t)((r >> 6) * NHEAD + (ck >> 6)) * 64 + (r & 63)) * 64 + (ck & 63)) = w; } }
        } else {
            const int cv0 = (u.pn - 4) * BM + wc * 32 + 8 * fq;
#pragma unroll
            for (int ai = 0; ai < 2; ++ai)
#pragma unroll
                for (int m = 0; m < 4; ++m) { const int r = row0 + ai * HALF + m * 16;
#pragma unroll
                    for (int bj = 0; bj < 2; ++bj) { const int cv = cv0 + bj * HALF; bf16_t* vp = VC + ((size_t)((r >> 6) * NHEAD + (cv >> 6)) * 64 + (cv & 63)) * 64 + (r & 63);
#pragma unroll
                        for (int n = 0; n < 2; ++n)
#pragma unroll
                            for (int j = 0; j < 4; ++j) vp[(4 * n + j) * 64] = (bf16_t)f2bf(acc[ai][bj][m][n][j] * rsv[ai][m]); } }
        }
    }
};
struct EpiResid {
    static constexpr bool PERM = true, AFTER_DRAIN = false, INIT = true;
    const float* base32; const bf16_t* base16; bf16_t* out; float* ssq;
    __device__ __forceinline__ void init(f32x4 (&acc)[2][2][4][2], const Unit& u, int wr, int wc, int fr, int fq) const {
        const int row0 = u.pm * BM + wr * 64 + fr, col0 = u.pn * BM + wc * 32 + 8 * fq;
#pragma unroll
        for (int ai = 0; ai < 2; ++ai)
#pragma unroll
            for (int m = 0; m < 4; ++m) { const size_t off = (size_t)(row0 + ai * HALF + m * 16) * D + col0;
#pragma unroll
                for (int bj = 0; bj < 2; ++bj) {
                    if (base32) { acc[ai][bj][m][0] = *(const f32x4*)(base32 + off + bj * HALF); acc[ai][bj][m][1] = *(const f32x4*)(base32 + off + bj * HALF + 4); }
                    else { const u32x4 w = *(const u32x4*)(base16 + off + bj * HALF);
                        acc[ai][bj][m][0] = (f32x4){bflo(w.x), bfhi(w.x), bflo(w.y), bfhi(w.y)}; acc[ai][bj][m][1] = (f32x4){bflo(w.z), bfhi(w.z), bflo(w.w), bfhi(w.w)}; } } }
    }
    __device__ __forceinline__ void operator()(const f32x4 (&acc)[2][2][4][2], const Unit& u, int wr, int wc, int fr, int fq) const {
        const int row0 = u.pm * BM + wr * 64 + fr, col0 = u.pn * BM + wc * 32 + 8 * fq;
#pragma unroll
        for (int ai = 0; ai < 2; ++ai)
#pragma unroll
            for (int m = 0; m < 4; ++m) { const size_t off = (size_t)(row0 + ai * HALF + m * 16) * D + col0; float ss = 0.f;
#pragma unroll
                for (int bj = 0; bj < 2; ++bj) { const f32x4 v0 = acc[ai][bj][m][0], v1 = acc[ai][bj][m][1];
                    ss += ((v0[0] * v0[0] + v0[1] * v0[1]) + (v0[2] * v0[2] + v0[3] * v0[3])) + ((v1[0] * v1[0] + v1[1] * v1[1]) + (v1[2] * v1[2] + v1[3] * v1[3]));
                    u32x4 w; w.x = cvt_pk_bf16(v0[0], v0[1]); w.y = cvt_pk_bf16(v0[2], v0[3]); w.z = cvt_pk_bf16(v1[0], v1[1]); w.w = cvt_pk_bf16(v1[2], v1[3]);
                    *(u32x4*)(out + off + bj * HALF) = w; }
                ss += shx(ss, 16); ss += shx(ss, 32);
                if (fq == 0) ssq[(size_t)(row0 + ai * HALF + m * 16) * 16 + 4 * u.pn + wc] = ss; }
    }
};
struct EpiSwiGLU {
    static constexpr bool PERM = true, AFTER_DRAIN = false;
    bf16_t* O; int ldc; const PG8_LAS float* rs;
    __device__ __forceinline__ void operator()(const f32x4 (&acc)[2][2][4][2], const Unit& u, int wr, int wc, int fr, int fq) const {
        const int row0 = u.pm * BM + wr * 64 + fr, col0 = u.pn * HALF + wc * 32 + 8 * fq;
#pragma unroll
        for (int ai = 0; ai < 2; ++ai)
#pragma unroll
            for (int m = 0; m < 4; ++m) { bf16_t* rowp = O + (size_t)(row0 + ai * HALF + m * 16) * ldc + col0;
                const float r_ = rs[256 * u.ui + wr * 64 + fr + ai * HALF + m * 16];
                float v[8];
#pragma unroll
                for (int n = 0; n < 2; ++n)
#pragma unroll
                    for (int j = 0; j < 4; ++j) { const float a = acc[ai][0][m][n][j] * r_, b = acc[ai][1][m][n][j] * r_; v[4 * n + j] = a * sigmoidf_(a) * b; }
                u32x4 w; w.x = cvt_pk_bf16(v[0], v[1]); w.y = cvt_pk_bf16(v[2], v[3]); w.z = cvt_pk_bf16(v[4], v[5]); w.w = cvt_pk_bf16(v[6], v[7]);
                *(u32x4*)rowp = w; }
    }
};
__device__ __forceinline__ unsigned pk4_fp8(float a, float b, float c, float d) { int r = 0; r = __builtin_amdgcn_cvt_pk_fp8_f32(a, b, r, false); r = __builtin_amdgcn_cvt_pk_fp8_f32(c, d, r, true); return (unsigned)r; }
struct EpiSwiGLU8 {
    static constexpr bool PERM = true, AFTER_DRAIN = false;
    unsigned char* O; static constexpr int ldc = FF;
    __device__ __forceinline__ void operator()(const f32x4 (&acc)[2][2][4][2], const Unit& u, int wr, int wc, int fr_, int fq_) const {
        int fr = fr_, fq = fq_; asm volatile("" : "+v"(fr), "+v"(fq));
        const int row0 = u.pm * BM + wr * 64 + fr, col0 = u.pn * HALF + wc * 32 + 8 * fq;
#pragma unroll
        for (int ai = 0; ai < 2; ++ai)
#pragma unroll
            for (int m = 0; m < 4; ++m) { unsigned char* rowp = O + (size_t)(row0 + ai * HALF + m * 16) * ldc + col0;
                float v[8];
#pragma unroll
                for (int n = 0; n < 2; ++n)
#pragma unroll
                    for (int j = 0; j < 4; ++j) { const float a = acc[ai][0][m][n][j], b = acc[ai][1][m][n][j]; v[4 * n + j] = a * sigmoidf_(a) * b; }
                *(u32x2*)rowp = (u32x2){pk4_fp8(v[0], v[1], v[2], v[3]), pk4_fp8(v[4], v[5], v[6], v[7])}; }
    }
};
struct EpiBf16 {
    static constexpr bool PERM = true, AFTER_DRAIN = false;
    bf16_t* O; int ldc;
    __device__ __forceinline__ void operator()(const f32x4 (&acc)[2][2][4][2], const Unit& u, int wr, int wc, int fr, int fq) const {
        const int row0 = u.pm * BM + wr * 64 + fr, col0 = u.pn * BM + wc * 32 + 8 * fq;
#pragma unroll
        for (int ai = 0; ai < 2; ++ai)
#pragma unroll
            for (int m = 0; m < 4; ++m) { bf16_t* rowp = O + (size_t)(row0 + ai * HALF + m * 16) * ldc + col0;
#pragma unroll
                for (int bj = 0; bj < 2; ++bj) { const f32x4 v0 = acc[ai][bj][m][0], v1 = acc[ai][bj][m][1];
                    u32x4 w; w.x = cvt_pk_bf16(v0[0], v0[1]); w.y = cvt_pk_bf16(v0[2], v0[3]); w.z = cvt_pk_bf16(v1[0], v1[1]); w.w = cvt_pk_bf16(v1[2], v1[3]);
                    *(u32x4*)(rowp + bj * HALF) = w; } }
    }
};
struct EpiGLU {
    static constexpr bool PERM = true, AFTER_DRAIN = true;
    const bf16_t* Y; bf16_t* MIXO; const float* gg;
    __device__ __forceinline__ void fused(f32x4 (&acc)[2][2][4][2], const Unit& u, int wr, int wc, int fr, int fq, PG8_LAS unsigned char* lds, int wid, int lane) const {
        PG8_LAS float* P = (PG8_LAS float*)lds;
        const int row0 = u.pm * BM + wr * 64 + fr, col0 = wc * 32 + 8 * fq;
#pragma unroll
        for (int ai = 0; ai < 2; ++ai)
#pragma unroll
            for (int m = 0; m < 4; ++m) { const bf16_t* yp = Y + (size_t)(row0 + ai * HALF + m * 16) * 256 + col0; float ss = 0.f;
#pragma unroll
                for (int bj = 0; bj < 2; ++bj) { const u32x4 yw = *(const u32x4*)(yp + bj * HALF);
                    const float yv[8] = {bflo(yw.x), bfhi(yw.x), bflo(yw.y), bfhi(yw.y), bflo(yw.z), bfhi(yw.z), bflo(yw.w), bfhi(yw.w)};
#pragma unroll
                    for (int n = 0; n < 2; ++n)
#pragma unroll
                        for (int j = 0; j < 4; ++j) { const float o = yv[4 * n + j] * sigmoidf_(acc[ai][bj][m][n][j]); acc[ai][bj][m][n][j] = o; ss += o * o; } }
                ss += shx(ss, 16); ss += shx(ss, 32);
                if (fq == 0) P[(ai * HALF + wr * 64 + m * 16 + fr) * 4 + wc] = ss; }
        asm volatile("s_waitcnt lgkmcnt(0)" ::: "memory"); __builtin_amdgcn_s_barrier(); asm volatile("" ::: "memory");
        f32x4 gv[2][2];
#pragma unroll
        for (int bj = 0; bj < 2; ++bj)
#pragma unroll
            for (int n = 0; n < 2; ++n) gv[bj][n] = *(const f32x4*)(gg + col0 + bj * HALF + 4 * n);
#pragma unroll
        for (int ai = 0; ai < 2; ++ai)
#pragma unroll
            for (int m = 0; m < 4; ++m) { const int rl = ai * HALF + wr * 64 + m * 16 + fr; const f32x4 p = *(const PG8_LAS f32x4*)(P + rl * 4);
                const float rstd = __builtin_amdgcn_rsqf(((p[0] + p[1]) + (p[2] + p[3])) * (1.0f / 256.0f) + EPS);
                bf16_t* rowp = MIXO + (size_t)(u.pm * BM + rl) * 1024 + col0;
#pragma unroll
                for (int bj = 0; bj < 2; ++bj) { const f32x4 v0 = acc[ai][bj][m][0] * rstd * gv[bj][0], v1 = acc[ai][bj][m][1] * rstd * gv[bj][1];
                    u32x4 w; w.x = cvt_pk_bf16(v0[0], v0[1]); w.y = cvt_pk_bf16(v0[2], v0[3]); w.z = cvt_pk_bf16(v1[0], v1[1]); w.w = cvt_pk_bf16(v1[2], v1[3]);
                    *(u32x4*)(rowp + bj * HALF) = w; } }
    }
};

template <class T, class = void> struct has_init { static constexpr bool value = false; };
template <class T> struct has_init<T, decltype((void)T::INIT)> { static constexpr bool value = true; };
struct OneUnit { int pm; __device__ __forceinline__ bool next(int i, Unit& u) const { if (i) return false; u.pm = pm; u.pn = 0; return true; } };
typedef int v8i_t __attribute__((ext_vector_type(8)));
typedef int v4i_t __attribute__((ext_vector_type(4)));
__device__ __forceinline__ const char* uptr(const char* p) { const unsigned long long v = (unsigned long long)p; const unsigned lo = (unsigned)__builtin_amdgcn_readfirstlane((int)(unsigned)v), hi = (unsigned)__builtin_amdgcn_readfirstlane((int)(unsigned)(v >> 32)); return (const char*)(((unsigned long long)hi << 32) | lo); }
__device__ __forceinline__ v8i_t ld8(const PG8_LAS unsigned char* p0, const PG8_LAS unsigned char* p1) { const v4i_t lo = *(const PG8_LAS v4i_t*)p0, hi = *(const PG8_LAS v4i_t*)p1; return __builtin_shufflevector(lo, hi, 0, 1, 2, 3, 4, 5, 6, 7); }
template <class Epi, bool ALIGN_EPI, bool GATHER, class Sched, int EB = 2>
__device__ __forceinline__ void gemm_phase(PG8_LAS unsigned char* lds, PG8_LAS int* tab, const Gemm g, const Sched& S, const Epi& E, int wave_in) {
    const bool use_e = (g.tile_e != nullptr);
    if (GATHER || use_e || g.ssq) {
        Unit uu; const int tp_ = wave_in * 64 + hw_lane();
        for (int i = 0; i < MAXU && S.next(i, uu); ++i) {
            if (tp_ == 0) tab[i] = use_e ? (int)__hip_atomic_load((const unsigned*)g.tile_e + uu.pm, RLX_AGENT) : 0;
            if (GATHER && tp_ < 256) tab[16 + 256 * i + tp_] = (int)__hip_atomic_load((const unsigned*)g.rowtok + uu.pm * 256 + tp_, RLX_AGENT);
            if (g.ssq && tp_ < 256) { const f32x4* p = (const f32x4*)(g.ssq + (size_t)(uu.pm * 256 + tp_) * 16); const f32x4 a = p[0], b = p[1], c = p[2], d = p[3];
                const float t = ((a[0] + a[1]) + (a[2] + a[3])) + ((b[0] + b[1]) + (b[2] + b[3])) + ((c[0] + c[1]) + (c[2] + c[3])) + ((d[0] + d[1]) + (d[2] + d[3]));
                tab[16 + 256 * i + tp_] = __builtin_bit_cast(int, __builtin_amdgcn_rsqf(t * (1.0f / 1024.0f) + EPS)); }
        }
        asm volatile("s_waitcnt vmcnt(0) lgkmcnt(0)" ::: "memory"); __syncthreads();
    }
    int tid_ = wave_in * 64 + hw_lane(); asm volatile("" : "+v"(tid_));
    const int tid = tid_, wid = __builtin_amdgcn_readfirstlane(tid >> 6), lane = tid & 63, wr = wid >> 2, wc = wid & 3, fr = lane & 15, fq = lane >> 4;
    int K_ = g.K; asm volatile("" : "+s"(K_));
    const int K = K_ * EB, nt = K / 128;
    int sR[2], sC[2];
    unsigned voffA[2], voffB[2];
#pragma unroll
    for (int i = 0; i < 2; ++i) { int R, C; stage_rc(tid * 16 + i * 8192, R, C); sR[i] = R; sC[i] = C; const int Rb = Epi::PERM ? ((R & ~31) + perm32(R & 31)) : R;
        voffA[i] = (unsigned)(R * K + C * 2); voffB[i] = (unsigned)(Rb * K + C * 2); }
    const unsigned kstep = 128u, d64 = (unsigned)(64 * K);
    const unsigned hstep = (unsigned)(HALF * K);
    const unsigned tstep = 2u * hstep;
    const unsigned hstepA = GATHER ? 0u : hstep;
    const __amdgpu_buffer_rsrc_t rW = __builtin_amdgcn_make_buffer_rsrc((void*)g.ws, 0, 0x7fffffff, 0x00020000);
    const unsigned baseA = (unsigned)((const unsigned char*)g.A - g.ws), baseB = (unsigned)((const unsigned char*)g.Bt - g.ws);
#define rA rW
#define rB rW
    const unsigned ldsw = (unsigned)wid * 1024u;
    constexpr int PSTEP = (EB == 2) ? 1024 : 16;
    const int aoff = lds_byte(wr * 64 + fr, (EB == 2) ? 8 * fq : 16 * fq), boff = lds_byte(wc * 32 + fr, (EB == 2) ? 8 * fq : 16 * fq);
    int boffB_ = boff + 4 * HTB; asm volatile("" : "+v"(boffB_));
    const PG8_LAS unsigned char* ldsB = lds + boffB_;
#define PG8_SA(b, h) (((b) * 2 + (h)) * HTB)
#define PG8_SB(b, h) ((4 + (b) * 2 + (h)) * HTB)
#define PG8_SBR(b, h) (((b) * 2 + (h)) * HTB)
#define PG8_STAGE(bufoff, rsrc, soff, voff) do { _Pragma("unroll") for (int _i = 0; _i < 2; ++_i) \
        __builtin_amdgcn_raw_ptr_buffer_load_lds(rsrc, (PG8_LAS void*)(lds + (bufoff) + ldsw + _i * 8192), 16, (int)(voff)[0], (int)((soff) + (unsigned)_i * d64), 0, 0); } while (0)
#define PG8_STAGE_A(bufoff, rsrc, soff, UI, H) do { if constexpr (GATHER) { _Pragma("unroll") for (int _i = 0; _i < 2; ++_i) { \
        const unsigned go_ = (unsigned)(tab[16 + 256 * (UI) + (H) * HALF + sR[_i]] * K + sC[_i] * 2); \
        __builtin_amdgcn_raw_ptr_buffer_load_lds(rsrc, (PG8_LAS void*)(lds + (bufoff) + ldsw + _i * 8192), 16, (int)go_, (int)(soff), 0, 0); } } else PG8_STAGE(bufoff, rsrc, soff, voffA); } while (0)
#define PG8_LDA(dst, b, h) do { if constexpr (EB == 2) { _Pragma("unroll") for (int m = 0; m < 4; ++m) _Pragma("unroll") for (int k = 0; k < 2; ++k) dst[m][k] = *(const PG8_LAS bf16x8*)(lds + PG8_SA(b, h) + aoff + m * 2048 + k * PSTEP); } \
        else { _Pragma("unroll") for (int m = 0; m < 4; ++m) dst##8[m] = ld8(lds + PG8_SA(b, h) + aoff + m * 2048, lds + PG8_SA(b, h) + aoff + m * 2048 + PSTEP); } } while (0)
#define PG8_LDB(dst, b, h) do { if constexpr (EB == 2) { _Pragma("unroll") for (int n = 0; n < 2; ++n) _Pragma("unroll") for (int k = 0; k < 2; ++k) dst[n][k] = *(const PG8_LAS bf16x8*)(ldsB + PG8_SBR(b, h) + n * 2048 + k * PSTEP); } \
        else { _Pragma("unroll") for (int n = 0; n < 2; ++n) dst##8[n] = ld8(ldsB + PG8_SBR(b, h) + n * 2048, ldsB + PG8_SBR(b, h) + n * 2048 + PSTEP); } } while (0)
#define PG8_MMA(ai, bj, At, Bt) do { __builtin_amdgcn_s_setprio(1); _Pragma("unroll") for (int m = 0; m < 4; ++m) _Pragma("unroll") for (int n = 0; n < 2; ++n) { \
        if constexpr (EB == 2) { _Pragma("unroll") for (int k = 0; k < 2; ++k) acc[ai][bj][m][n] = __builtin_amdgcn_mfma_f32_16x16x32_bf16(Bt[n][k], At[m][k], acc[ai][bj][m][n], 0, 0, 0); } \
        else acc[ai][bj][m][n] = __builtin_amdgcn_mfma_scale_f32_16x16x128_f8f6f4(Bt##8[n], At##8[m], acc[ai][bj][m][n], 0, 0, 0, 0x79797979  , 0, 0x7f7f7f7f  ); } \
        __builtin_amdgcn_s_setprio(0); } while (0)
#define PG8_WAIT_V(n) asm volatile("s_waitcnt vmcnt(" #n ")" ::: "memory")
#define PG8_WAIT_L(n) asm volatile("s_waitcnt lgkmcnt(" #n ")" ::: "memory")
#define PG8_BAR __builtin_amdgcn_s_barrier()
#define PG8_SCHED __builtin_amdgcn_sched_barrier(0)
#define PG8_ABASE(pm_) (baseA + (GATHER ? 0u : (unsigned)(pm_) * tstep))
#define PG8_BBASE(ui_, pn_) (baseB + (use_e ? (unsigned)tab[(ui_)] * (unsigned)(g.estride * EB) : 0u) + (unsigned)(pn_) * tstep)
    Unit cur, nxt; int ui = 0;
    if (!S.next(0, cur)) return;
    cur.ui = 0;
    float zero_ = 0.f; asm volatile("" : "+v"(zero_));
    f32x4 acc[2][2][4][2];
    if constexpr (has_init<Epi>::value) { E.init(acc, cur, wr, wc, fr, fq); }
    else {
#pragma unroll
    for (int a = 0; a < 2; ++a)
#pragma unroll
        for (int b = 0; b < 2; ++b)
#pragma unroll
            for (int m = 0; m < 4; ++m)
#pragma unroll
                for (int n = 0; n < 2; ++n) acc[a][b][m][n] = (f32x4){zero_, zero_, zero_, zero_}; }
    bf16x8 At[4][2], B0[2][2], B1[2][2];
    v8i_t At8[4], B08[2], B18[2];
    (void)At; (void)B0; (void)B1; (void)At8; (void)B08; (void)B18;
    unsigned cA = PG8_ABASE(cur.pm), cB = PG8_BBASE(0, cur.pn);
    PG8_STAGE(PG8_SB(0, 0), rB, cB, voffB); PG8_STAGE(PG8_SB(0, 1), rB, cB + hstep, voffB); PG8_STAGE_A(PG8_SA(0, 0), rA, cA, 0, 0); PG8_STAGE_A(PG8_SA(0, 1), rA, cA + hstepA, 0, 1);
    if (wr == 1) PG8_BAR;
    PG8_WAIT_V(2); PG8_BAR;
    PG8_STAGE(PG8_SB(1, 0), rB, cB + kstep, voffB); PG8_STAGE_A(PG8_SA(1, 0), rA, cA + kstep, 0, 0); PG8_STAGE(PG8_SB(1, 1), rB, cB + hstep + kstep, voffB);
    PG8_WAIT_V(6); PG8_BAR;
    for (;;) {
        const bool has_next = S.next(ui + 1, nxt); nxt.ui = ui + 1;
        const unsigned nA = has_next ? PG8_ABASE(nxt.pm) : cA, nB = has_next ? PG8_BBASE(ui + 1, nxt.pn) : cB;
#pragma unroll 1
        for (int t = 0; t < nt; t += 2) {
            const bool last = (t == nt - 2);
            const unsigned a1 = cA + (unsigned)(t + 1) * kstep;
            const unsigned a2 = last ? nA : cA + (unsigned)(t + 2) * kstep, b2 = last ? nB : cB + (unsigned)(t + 2) * kstep;
            const unsigned a3 = a2 + kstep, b3 = b2 + kstep;
            const int uis = (last && has_next) ? ui + 1 : ui; (void)uis;
            PG8_LDB(B0, 0, 0); PG8_LDB(B1, 0, 1); PG8_SCHED; PG8_LDA(At, 0, 0); PG8_STAGE_A(PG8_SA(1, 1), rA, a1 + hstepA, ui, 1);
            PG8_WAIT_V(8); PG8_WAIT_L(0); PG8_BAR; PG8_MMA(0, 0, At, B0); PG8_MMA(0, 1, At, B1); PG8_BAR; PG8_SCHED;
            PG8_LDA(At, 0, 1); PG8_STAGE(PG8_SB(0, 0), rB, b2, voffB); PG8_STAGE(PG8_SB(0, 1), rB, b2 + hstep, voffB); PG8_STAGE_A(PG8_SA(0, 0), rA, a2, uis, 0);
            PG8_WAIT_V(8); PG8_WAIT_L(0); PG8_BAR; PG8_MMA(1, 0, At, B0); PG8_MMA(1, 1, At, B1); PG8_BAR; PG8_SCHED;
            PG8_LDB(B0, 1, 0); PG8_LDB(B1, 1, 1); PG8_SCHED; PG8_LDA(At, 1, 0); PG8_STAGE_A(PG8_SA(0, 1), rA, a2 + hstepA, uis, 1);
            PG8_WAIT_V(8); PG8_WAIT_L(0); PG8_BAR; PG8_MMA(0, 0, At, B0); PG8_MMA(0, 1, At, B1); PG8_BAR; PG8_SCHED;
            PG8_LDA(At, 1, 1); PG8_STAGE(PG8_SB(1, 0), rB, b3, voffB); PG8_STAGE(PG8_SB(1, 1), rB, b3 + hstep, voffB); PG8_STAGE_A(PG8_SA(1, 0), rA, a3, uis, 0);
            PG8_WAIT_V(8); PG8_WAIT_L(0); PG8_BAR; PG8_MMA(1, 0, At, B0); PG8_MMA(1, 1, At, B1); PG8_BAR; PG8_SCHED;
        }
        if constexpr (ALIGN_EPI) { if (wr == 0) PG8_BAR; }
        if constexpr (!Epi::AFTER_DRAIN) { const int el_ = hw_lane(); E(acc, cur, wr, wc, el_ & 15, el_ >> 4); }
        if (!has_next) break;
        if constexpr (has_init<Epi>::value) { const int el2_ = hw_lane(); E.init(acc, nxt, wr, wc, el2_ & 15, el2_ >> 4); }
        else { float z2_ = 0.f; asm volatile("" : "+v"(z2_));
#pragma unroll
        for (int a = 0; a < 2; ++a)
#pragma unroll
            for (int b = 0; b < 2; ++b)
#pragma unroll
                for (int m = 0; m < 4; ++m)
#pragma unroll
                    for (int n = 0; n < 2; ++n) acc[a][b][m][n] = (f32x4){z2_, z2_, z2_, z2_}; }
        cur = nxt; cA = nA; cB = nB; ++ui;
        if constexpr (ALIGN_EPI) { if (wr == 1) PG8_BAR; }
    }
    PG8_WAIT_V(0);
    if constexpr (!ALIGN_EPI) { if (wr == 0) PG8_BAR; }
    PG8_BAR;
    if constexpr (Epi::AFTER_DRAIN) { const int el_ = hw_lane(); E.fused(acc, cur, wr, wc, el_ & 15, el_ >> 4, lds, wid, el_); }
#undef PG8_SA
#undef PG8_SB
#undef PG8_STAGE
#undef PG8_STAGE_A
#undef PG8_LDA
#undef PG8_LDB
#undef PG8_MMA
#undef PG8_WAIT_V
#undef PG8_WAIT_L
#undef PG8_BAR
#undef PG8_SCHED
#undef PG8_ABASE
#undef PG8_BBASE
#undef rA
#undef rB
}
}

constexpr size_t MiB = 1u << 20;
constexpr size_t WS_CTL = 0, CTL_ZERO_BYTES = 1 * MiB;
constexpr size_t WS_TAB = 1 * MiB, TAB_L = 10 * MiB;
constexpr size_t TB_KMAT = 0, TB_WIN = 1 * MiB, TB_WOUT = 5 * MiB, TB_APT = 9 * MiB, TB_RGWX = 9 * MiB + 65536, TB_RGWA = 9 * MiB + 131072, TB_WGLU = 9 * MiB + 262144;
constexpr size_t WS_WINT = 21 * MiB, WINT_L = (size_t)D_IN * D * 2;
constexpr size_t WS_WOUTT = 30 * MiB, WOUTT_L = (size_t)D * D * 2;
constexpr size_t WS_F13 = 34 * MiB, WS_F2 = 45 * MiB;
constexpr size_t WS_M2 = 51 * MiB, WS_M13 = 95 * MiB;
constexpr size_t E13 = (size_t)2 * FF * D, E2 = (size_t)D * FF;
constexpr size_t WS_OVL = 183 * MiB;
constexpr size_t WS_XN = WS_OVL, WS_QK = 215 * MiB, WS_VT = 247 * MiB, WS_RGS = 263 * MiB, WS_RGH = 287 * MiB, WS_RGA = 303 * MiB, WS_MIX = 319 * MiB, WS_S5Y = 351 * MiB,
                 WS_SLOC = 359 * MiB, WS_RGCP = 361 * MiB, WS_RGCH = 361 * MiB + 262144;
constexpr size_t WS_KC = WS_QK + 16 * MiB;
constexpr size_t WS_ACT0 = 215 * MiB, WS_ACT1 = 215 * MiB;
constexpr size_t WS_SSQ = 362 * MiB;
constexpr size_t WS_XNM = 1 * MiB, WS_TOKINFO = 36 * MiB, WS_POS = 36 * MiB + 262144, WS_ROWTOK = 36 * MiB + 524288, WS_YEXP = 95 * MiB;
constexpr size_t WS_HG8 = 320 * MiB;
constexpr size_t WS_END = 370 * MiB;
static_assert(WS_ACT1 + (size_t)PMAX * FF <= WS_HG8 && WS_HG8 + (size_t)PMAX * D <= WS_SSQ && WS_YEXP + (size_t)PMAX * D * 2 <= WS_OVL && WS_ACT0 + (size_t)M * FF * 2 <= WS_END, "ws map");
static_assert(WS_M13 + NE * E13 * 2 <= WS_OVL && WS_M2 + NE * E2 * 2 <= WS_M13 && WS_F2 + E2 * 2 <= WS_M2 && WS_F13 + E13 * 2 <= WS_F2, "ws map weights");
constexpr int CW_TMO = 0, CW_BAR = 4096, CW_CNT = 8192, CW_ROUTE = 12288, CW_TILEE = 12544;

constexpr int RING_BYTES = 131072, TAB_OFF = RING_BYTES, TAB_BYTES = 12544, MISC_OFF = TAB_OFF + TAB_BYTES, LDS_BYTES = 147456;
static_assert(MISC_OFF + 128 <= LDS_BYTES, "LDS map");
constexpr int NWAVES = 8;

#define XB_TMO      128
#define XB_XCNT(j)  (256  + 64 * (j))
#define XB_XSUB(j)  (1280 + 64 * (j))
#define XB_XGEN(j)  (2304 + 64 * (j))
#define XB_TOP      3328
#define XB_TOPGEN   3392
#define XCD_BAR_WORDS 3456
#define XB_SPIN_CAP (1u << 18)
__device__ __forceinline__ unsigned xb_ld(unsigned* p)              { return __hip_atomic_load(p, __ATOMIC_RELAXED, __HIP_MEMORY_SCOPE_AGENT); }
__device__ __forceinline__ unsigned xb_add(unsigned* p, unsigned v) { return __hip_atomic_fetch_add(p, v, __ATOMIC_RELAXED, __HIP_MEMORY_SCOPE_AGENT); }
__device__ __forceinline__ unsigned xb_xcc_id() { return (unsigned)__builtin_amdgcn_s_getreg((3 << 11) | 20) & 0xFu; }
#define XB_SPIN(cond, bar) do { unsigned _sp = 0; while (cond) { __builtin_amdgcn_s_sleep(1); \
    if ((++_sp & 255u) == 0u) { if (xb_ld(&(bar)[XB_TMO])) break; if (_sp > XB_SPIN_CAP) { atomicAdd(&(bar)[XB_TMO], 1u); break; } } } } while (0)
struct XcdBarrier { unsigned* bar; unsigned x; volatile LAS unsigned* st; bool leader; };
__device__ __forceinline__ XcdBarrier xcd_barrier_post(unsigned* bar, volatile LAS unsigned* st, bool leader) {
    XcdBarrier b; b.bar = bar; b.x = xb_xcc_id(); b.st = st; b.leader = leader;
    if (b.leader) st[12] = xb_add(&bar[XB_XCNT(b.x)], 1u);
    return b;
}
__device__ __forceinline__ void xcd_barrier_complete(unsigned* bar, unsigned x, unsigned& nloc, unsigned& nx, bool& uni) {
    const unsigned G = gridDim.x * gridDim.y * gridDim.z;
    unsigned sum, cnt, mine, sp = 0u;
    for (;;) {
        sum = 0u; cnt = 0u; mine = 0u;
#pragma unroll
        for (unsigned j = 0; j < 16; ++j) { const unsigned c = xb_ld(&bar[XB_XCNT(j)]); sum += c; cnt += (c > 0u) ? 1u : 0u; mine = (j == x) ? c : mine; }
        if (sum == G) break;
        __builtin_amdgcn_s_sleep(1);
        if ((++sp & 255u) == 0u) { if (xb_ld(&bar[XB_TMO])) break; if (sp > XB_SPIN_CAP) { atomicAdd(&bar[XB_TMO], 1u); break; } }
    }
    nloc = mine > 0u ? mine : 1u; nx = cnt > 0u ? cnt : 1u;
    uni = (G % 8u == 0u);
#pragma unroll
    for (unsigned j = 0; j < 16; ++j) { const unsigned c = xb_ld(&bar[XB_XCNT(j)]); uni = uni && (c == (j < 8u ? G / 8u : 0u)); }
}
__device__ __forceinline__ void xcd_barrier(const XcdBarrier& b) {
    asm volatile("s_waitcnt vmcnt(0)" ::: "memory");
    __syncthreads();
    if (b.leader) {
        unsigned* bar = b.bar;
        __builtin_amdgcn_s_waitcnt(0);
        unsigned nloc = b.st[0], nx = b.st[1];
        if (nloc == 0u) { bool uni; xcd_barrier_complete(bar, b.x, nloc, nx, uni); b.st[0] = nloc; b.st[1] = nx;
            b.st[13] = uni ? (b.st[12] * 8u + b.x) + 1u : 0u; }
        const unsigned old = xb_add(&bar[XB_XSUB(b.x)], 1u);
        const unsigned gen = old / nloc;
        if (old + 1u == (gen + 1u) * nloc) {
            __builtin_amdgcn_fence(__ATOMIC_RELEASE, "agent");
            asm volatile("s_waitcnt vmcnt(0)" ::: "memory");
            (void)xb_add(&bar[XB_TOP], 1u);
        }
        XB_SPIN(xb_ld(&bar[XB_TOP]) < (gen + 1u) * nx, bar);
        __builtin_amdgcn_fence(__ATOMIC_ACQUIRE, "agent");
        asm volatile("s_waitcnt vmcnt(0)" ::: "memory");
    }
    __syncthreads();
}

struct Inputs {
    const float *x, *norm_mix_g, *w_in, *rel_bias, *rg_conv_w, *rg_conv_b, *rg_wx, *rg_bx, *rg_wa, *rg_ba, *rg_lambda,
                *s5_a_re, *s5_a_im, *s5_log_dt, *s5_b_re, *s5_b_im, *s5_c_re, *s5_c_im, *s5_d, *s5_w_glu, *g_group, *w_out, *norm_ffn_g,
                *ffn_w1, *ffn_w3, *ffn_w2, *moe_router, *moe_w1, *moe_w3, *moe_w2, *final_norm_g;
};
struct Args { Inputs in; float* out; unsigned char* ws; int ph_lo, ph_hi; };
struct Frame {
    LAS unsigned char* lds;
    unsigned char* ws;
    gu32* ctl;
    int tid, lane, wave, G, wg;
    const __attribute__((address_space(4))) struct Args* ka;
    float* out;
};
template <class T> __device__ __forceinline__ T* wsp(const Frame& F, size_t off) { return (T*)(F.ws + off); }

__device__ __forceinline__ void p0_transpose_item(const float* W, int K, int N, bf16_t* WT, int row_off, int mode, LAS float* scr, int item, int lane) {
    const int nblk = N / 32, kb = item / nblk, nb = item % nblk, k0 = 64 * kb, n0 = 32 * nb;
#pragma unroll 8
    for (int i = 0; i < 32; ++i) { const int kk = 2 * i + (lane >> 5); scr[kk * 33 + (lane & 31)] = W[(size_t)(k0 + kk) * N + n0 + (lane & 31)]; }
    LDS_WAIT(); asm volatile("" ::: "memory");
    const int c = lane & 7;
    const int drow0 = (mode == 0) ? (row_off + n0) : (256 * (n0 >> 7) + (n0 & 127) + (mode == 2 ? 128 : 0));
#pragma unroll
    for (int j = 0; j < 4; ++j) { const int n = (lane >> 3) + 8 * j; const LAS float* s = scr + (8 * c) * 33 + n;
        u32x4 o; o.x = pk2(s[0 * 33], s[1 * 33]); o.y = pk2(s[2 * 33], s[3 * 33]); o.z = pk2(s[4 * 33], s[5 * 33]); o.w = pk2(s[6 * 33], s[7 * 33]);
        *(GAS u32x4*)(WT + (size_t)(drow0 + n) * K + k0 + 8 * c) = o; }
    LDS_WAIT(); asm volatile("" ::: "memory");
}
struct TrJob { const float* W; bf16_t* WT; int K, N, mode, fp8; const float* gk; };
__device__ __forceinline__ void tr_load(const TrJob& j, int tile, int tid, f32x4 (&v)[8]) {
    const int ntn = j.N >> 7, kb = tile / ntn, nb = tile - kb * ntn;
    const float* src = j.W + (size_t)(128 * kb + (tid >> 5)) * j.N + 128 * nb + 4 * (tid & 31);
#pragma unroll
    for (int i = 0; i < 8; ++i) v[i] = __builtin_nontemporal_load((const f32x4*)(src + (size_t)(16 * i) * j.N));
}
__device__ __forceinline__ void tr_store(const TrJob& j, int tile, int tid, const f32x4 (&v)[8], LAS unsigned* T) {
    const int ntn = j.N >> 7, kb = tile / ntn, nb = tile - kb * ntn;
#pragma unroll
    for (int i = 0; i < 8; ++i) { const int k = (tid >> 5) + 16 * i; const int dw = (2 * (tid & 31)) ^ (2 * ((k >> 3) & 15));
        const float gq = j.gk ? j.gk[128 * kb + k] : 1.0f;
        *(LAS u32x2*)(T + k * 64 + dw) = (u32x2){pk2(v[i].x * gq, v[i].y * gq), pk2(v[i].z * gq, v[i].w * gq)}; }
    LDS_WAIT(); __syncthreads();
    const int drow0 = (j.mode == 0) ? 128 * nb : (256 * nb + (j.mode == 2 ? 128 : 0));
    const LAS unsigned short* T16 = (const LAS unsigned short*)T;
    if (j.fp8) {
        const int kc = tid & 7;
#pragma unroll
        for (int r = 0; r < 2; ++r) { const int n = (tid >> 3) + 64 * r; unsigned o4[4];
#pragma unroll
            for (int q4 = 0; q4 < 4; ++q4) { float f[4];
#pragma unroll
                for (int q = 0; q < 4; ++q) { const int k = 16 * kc + 4 * q4 + q; const int e0 = 2 * ((n >> 1) ^ (2 * ((k >> 3) & 15))) + (n & 1); f[q] = bf2f(T16[k * 128 + e0]) * 64.0f; }
                o4[q4] = pg8::pk4_fp8(f[0], f[1], f[2], f[3]); }
            *(GAS u32x4*)((unsigned char*)j.WT + (size_t)(drow0 + n) * j.K + 128 * kb + 16 * kc) = (u32x4){o4[0], o4[1], o4[2], o4[3]}; }
    } else {
    const int kc = tid & 15;
#pragma unroll
    for (int r = 0; r < 4; ++r) { const int n = (tid >> 4) + 32 * r; const int e0 = 2 * ((n >> 1) ^ (2 * kc)) + (n & 1);
        unsigned h[8];
#pragma unroll
        for (int q = 0; q < 8; ++q) h[q] = T16[(8 * kc + q) * 128 + e0];
        u32x4 o; o.x = h[0] | (h[1] << 16); o.y = h[2] | (h[3] << 16); o.z = h[4] | (h[5] << 16); o.w = h[6] | (h[7] << 16);
        *(GAS u32x4*)(j.WT + (size_t)(drow0 + n) * j.K + 128 * kb + 8 * kc) = o; }
    }
    LDS_WAIT(); __syncthreads();
}
__device__ __forceinline__ void rms_row_to_bf16(int lane, const float* xrow, const float* g, bf16_t* orow) {
    const GAS f32x4* xr = (const GAS f32x4*)xrow + lane; const GAS f32x4* gr = (const GAS f32x4*)g + lane;
    f32x4 v[4]; float s = 0.f;
#pragma unroll
    for (int j = 0; j < 4; ++j) { v[j] = xr[64 * j]; s += (v[j].x * v[j].x + v[j].y * v[j].y) + (v[j].z * v[j].z + v[j].w * v[j].w); }
    const float rstd = 1.f / sqrtf(wave_sum(s) * (1.f / D) + EPS);
    GAS unsigned long long* o8 = (GAS unsigned long long*)orow + lane;
#pragma unroll
    for (int j = 0; j < 4; ++j) { const f32x4 gg = gr[64 * j]; o8[64 * j] = (unsigned long long)pk2(v[j].x * rstd * gg.x, v[j].y * rstd * gg.y) | ((unsigned long long)pk2(v[j].z * rstd * gg.z, v[j].w * rstd * gg.w) << 32); }
}
__device__ __forceinline__ void stream_phase(Frame& F, const float* src, bf16_t* dst, float* ssq) {
    const int gw = F.wg * NWAVES + F.wave, NGW = F.G * NWAVES;
    constexpr int RB = 4;
    for (int m0 = gw; m0 < M; m0 += NGW * RB) {
        f32x4 v[RB][4]; float s[RB];
#pragma unroll
        for (int q = 0; q < RB; ++q) { const int m = m0 + q * NGW; const GAS f32x4* xr = (const GAS f32x4*)(src + (size_t)(m < M ? m : m0) * D) + F.lane;
#pragma unroll
            for (int j = 0; j < 4; ++j) v[q][j] = xr[64 * j]; }
#pragma unroll
        for (int q = 0; q < RB; ++q) { float a = 0.f;
#pragma unroll
            for (int j = 0; j < 4; ++j) a += (v[q][j].x * v[q][j].x + v[q][j].y * v[q][j].y) + (v[q][j].z * v[q][j].z + v[q][j].w * v[q][j].w);
            s[q] = a; }
#pragma unroll
        for (int o = 1; o < 64; o <<= 1)
#pragma unroll
            for (int q = 0; q < RB; ++q) s[q] += shx(s[q], o);
#pragma unroll
        for (int q = 0; q < RB; ++q) { const int m = m0 + q * NGW; if (m >= M) break;
            GAS unsigned long long* o8 = (GAS unsigned long long*)(dst + (size_t)m * D) + F.lane;
#pragma unroll
            for (int j = 0; j < 4; ++j) o8[64 * j] = (unsigned long long)pk2(v[q][j].x, v[q][j].y) | ((unsigned long long)pk2(v[q][j].z, v[q][j].w) << 32);
            if (F.lane < 16) ssq[(size_t)m * 16 + F.lane] = F.lane == 0 ? s[q] : 0.f; }
    }
}
__device__ __forceinline__ void s5_pow(float are, float aim, float dt, int k, float& pr, float& pi) {
    const float mag = expf(are * dt * (float)k);
    double ph = (double)aim * (double)dt * (double)k; ph -= 6.283185307179586476925 * rint(ph * 0.15915494309189533577);
    float s, c; sincosf((float)ph, &s, &c); pr = mag * c; pi = mag * s;
}
__device__ __forceinline__ void s5_q(float are, float aim, float dt, float& qr, float& qi) {
    const float zr = are * dt, zi = aim * dt;
    float s, c; sincosf(zi, &s, &c); const float sh = sinf(0.5f * zi);
    const float em1 = expm1f(zr), e = em1 + 1.0f;
    const float nr = em1 * c - 2.0f * sh * sh, ni = e * s;
    const float den = are * are + aim * aim;
    qr = (nr * are + ni * aim) / den; qi = (ni * are - nr * aim) / den;
}
__device__ __forceinline__ void p0_tables(Frame& F, int l) {
    const int gt = F.wg * 512 + F.tid, NT = F.G * 512;
    const float* are_ = F.ka->in.s5_a_re + l * S5G * S5P; const float* aim_ = F.ka->in.s5_a_im + l * S5G * S5P; const float* ldt_ = F.ka->in.s5_log_dt + l * S5G;
    const float* bre_ = F.ka->in.s5_b_re + (size_t)l * S5G * S5P * S5C; const float* bim_ = F.ka->in.s5_b_im + (size_t)l * S5G * S5P * S5C;
    const float* cre_ = F.ka->in.s5_c_re + (size_t)l * S5G * S5C * S5P; const float* cim_ = F.ka->in.s5_c_im + (size_t)l * S5G * S5C * S5P;
    unsigned char* tb = F.ws + WS_TAB + l * TAB_L;
    bf16_t* KMAT = (bf16_t*)(tb + TB_KMAT); bf16_t* WIN = (bf16_t*)(tb + TB_WIN); bf16_t* WOUT = (bf16_t*)(tb + TB_WOUT); float* APT = (float*)(tb + TB_APT);
    for (int it = gt; it < S5G * S5P * CHUNK; it += NT) {
        const int s = it & 63, p = (it >> 6) & 63, g = it >> 12;
        const float are = are_[g * S5P + p], aim = aim_[g * S5P + p], dt = expf(ldt_[g]);
        float pr, pi, qr, qi; s5_pow(are, aim, dt, CHUNK - 1 - s, pr, pi); s5_q(are, aim, dt, qr, qi);
        const float wr_ = pr * qr - pi * qi, wi_ = pr * qi + pi * qr;
        bf16_t* o_re = WIN + ((size_t)(g * 128 + p) * 1024 + s * 16); bf16_t* o_im = WIN + ((size_t)(g * 128 + 64 + p) * 1024 + s * 16);
#pragma unroll
        for (int ci = 0; ci < 16; ++ci) { const float br = bre_[(g * S5P + p) * S5C + ci], bi = bim_[(g * S5P + p) * S5C + ci];
            o_re[ci] = (bf16_t)f2bf(wr_ * br - wi_ * bi); o_im[ci] = (bf16_t)f2bf(wr_ * bi + wi_ * br); }
        if (s == 0) { float ar, ai; s5_pow(are, aim, dt, CHUNK, ar, ai); APT[(g * S5P + p) * 2] = ar; APT[(g * S5P + p) * 2 + 1] = ai; }
    }
    for (int it = gt; it < S5G * CHUNK * S5P; it += NT) {
        const int p = it & 63, t = (it >> 6) & 63, g = it >> 12;
        float pr, pi; s5_pow(are_[g * S5P + p], aim_[g * S5P + p], expf(ldt_[g]), t + 1, pr, pi);
        bf16_t* o = WOUT + (size_t)(g * 1024 + t * 16) * 128 + p;
#pragma unroll 4
        for (int co = 0; co < 16; ++co) { const float cr = cre_[(g * S5C + co) * S5P + p], ci = cim_[(g * S5C + co) * S5P + p];
            o[co * 128] = (bf16_t)f2bf(cr * pr - ci * pi); o[co * 128 + 64] = (bf16_t)f2bf(-(cr * pi + ci * pr)); }
    }
    { LAS float* wl = (LAS float*)F.lds;
      LAS float* Cr = wl + 256; LAS float* Ci = Cr + 1024; LAS float* Br = Ci + 1024; LAS float* Bi = Br + 1024;
      const int half = F.tid >> 8, co = (F.tid >> 4) & 15, ci = F.tid & 15;
      for (int item = F.wg; item < S5G * 33; item += F.G) {
          const int g = item / 33, li0 = 2 * (item % 33);
          for (int i = F.tid; i < 1024; i += 512) { Cr[i] = cre_[g * 1024 + i]; Ci[i] = cim_[g * 1024 + i]; Br[i] = bre_[g * 1024 + i]; Bi[i] = bim_[g * 1024 + i]; }
          if ((F.tid & 255) < 64) { const int p = F.tid & 63, li = li0 + half; float wr_ = 0.f, wi_ = 0.f;
              if (li >= 1 && li <= 64) { const float are = are_[g * S5P + p], aim = aim_[g * S5P + p], dt = expf(ldt_[g]); float pr, pi, qr, qi; s5_pow(are, aim, dt, li - 1, pr, pi); s5_q(are, aim, dt, qr, qi);
                  wr_ = pr * qr - pi * qi; wi_ = pr * qi + pi * qr; }
              wl[(half * 64 + p) * 2] = wr_; wl[(half * 64 + p) * 2 + 1] = wi_; }
          LDS_WAIT(); __syncthreads();
          const int li = li0 + half;
          if (li <= 64) { float a = 0.f;
#pragma unroll 8
              for (int p = 0; p < S5P; ++p) { const float wr_ = wl[(half * 64 + p) * 2], wi_ = wl[(half * 64 + p) * 2 + 1];
                  const float cr = Cr[co * 64 + p], cim = Ci[co * 64 + p], br = Br[p * 16 + ci], bi = Bi[p * 16 + ci];
                  a += (cr * wr_ - cim * wi_) * br - (cr * wi_ + cim * wr_) * bi; }
              KMAT[(size_t)((g * 65 + li) * 16 + co) * 16 + ci] = (bf16_t)f2bf(a); }
          __syncthreads();
      } }
    bf16_t* WXT = (bf16_t*)(tb + TB_RGWX); bf16_t* WAT = (bf16_t*)(tb + TB_RGWA);
    const float* wx = F.ka->in.rg_wx + (size_t)l * 4 * 64 * 64; const float* wa = F.ka->in.rg_wa + (size_t)l * 4 * 64 * 64;
    for (int it = gt; it < 4 * 64 * 64; it += NT) { const int i = it & 63, o = (it >> 6) & 63, hb = it >> 12;
        WXT[it] = (bf16_t)f2bf(wx[(hb * 64 + i) * 64 + o]); WAT[it] = (bf16_t)f2bf(wa[(hb * 64 + i) * 64 + o]); }
}
__device__ __forceinline__ TrJob p0_job(const Frame& F, int it, int& tile) {
    constexpr int T_IN = (D / 128) * (D_IN / 128), T_OUT = (D / 128) * (D / 128), T_UP = (D / 128) * (FF / 128), T_DN = (FF / 128) * (D / 128), T_GLU = 4;
    int r = it; TrJob j;
    if (r < 2 * T_IN) { const int l = r / T_IN; tile = r % T_IN; j = TrJob{F.ka->in.w_in + (size_t)l * D * D_IN, wsp<bf16_t>(F, WS_WINT + l * WINT_L), D, D_IN, 0, 0, F.ka->in.norm_mix_g + l * D}; return j; } r -= 2 * T_IN;
    if (r < 2 * T_OUT) { const int l = r / T_OUT; tile = r % T_OUT; j = TrJob{F.ka->in.w_out + (size_t)l * D * D, wsp<bf16_t>(F, WS_WOUTT + l * WOUTT_L), D, D, 0, 0, nullptr}; return j; } r -= 2 * T_OUT;
    if (r < 2 * T_GLU) { const int l = r / T_GLU; tile = r % T_GLU; j = TrJob{F.ka->in.s5_w_glu + (size_t)l * 256 * 256, wsp<bf16_t>(F, WS_TAB + l * TAB_L + TB_WGLU), 256, 256, 0, 0, nullptr}; return j; } r -= 2 * T_GLU;
    int e, part;
    if (r < 2 * T_UP + T_DN) { e = 0; part = r / T_UP; r -= part * T_UP; }
    else { r -= 2 * T_UP + T_DN;
        if (r < NE * 2 * T_UP) { e = 1 + r / (2 * T_UP); r -= (e - 1) * 2 * T_UP; part = r / T_UP; r -= part * T_UP; }
        else { r -= NE * 2 * T_UP; e = 1 + r / T_DN; r -= (e - 1) * T_DN; part = 2; } }
    tile = r;
    if (part == 2) { const float* w2 = e ? F.ka->in.moe_w2 + (size_t)(e - 1) * FF * D : F.ka->in.ffn_w2; bf16_t* d2 = e ? (bf16_t*)(F.ws + WS_M2 + (size_t)(e - 1) * E2) : wsp<bf16_t>(F, WS_F2);
        j = TrJob{w2, d2, FF, D, 0, e ? 1 : 0, nullptr}; return j; }
    const float* w13 = part ? (e ? F.ka->in.moe_w3 + (size_t)(e - 1) * D * FF : F.ka->in.ffn_w3) : (e ? F.ka->in.moe_w1 + (size_t)(e - 1) * D * FF : F.ka->in.ffn_w1);
    bf16_t* d13 = e ? (bf16_t*)(F.ws + WS_M13 + (size_t)(e - 1) * E13) : wsp<bf16_t>(F, WS_F13);
    j = TrJob{w13, d13, D, FF, 1 + part, e ? 1 : 0, e ? nullptr : F.ka->in.norm_ffn_g}; return j;
}
__device__ __forceinline__ void convert_jobs(Frame& F, int first, int end, int stride) {
    LAS unsigned* T = (LAS unsigned*)F.lds;
    f32x4 v[8]; int tile = 0, ntile = 0; TrJob cur{}, nxt{};
    int it = first;
    if (it < end) { cur = p0_job(F, it, tile); tr_load(cur, tile, F.tid, v); }
    while (it < end) {
        f32x4 w[8];
#pragma unroll
        for (int i = 0; i < 8; ++i) w[i] = v[i];
        const int itn = it + stride;
        if (itn < end) { nxt = p0_job(F, itn, ntile); tr_load(nxt, ntile, F.tid, v); }
        tr_store(cur, tile, F.tid, w, T);
        cur = nxt; tile = ntile; it = itn;
    }
}
constexpr int JOB_MOE0 = 952, JOB_W2 = JOB_MOE0 + NE * 352, JOB_END = 5176, BG_P0 = 768;
constexpr int BG_A0 = JOB_MOE0 + BG_P0;
constexpr int BG_C0 = BG_A0 + 768;
constexpr int BG_D0 = BG_C0 + 512;
static_assert(BG_D0 + 768 == JOB_W2 && JOB_W2 + NE * 176 == JOB_END && BG_P0 == 2 * 3 * (256 - S5G * 8), "background conversion slots cover every expert tile");
constexpr int BG_F_PER = 4;
__device__ __forceinline__ void p0_prologue(Frame& F) {
    convert_jobs(F, F.wg, JOB_MOE0, F.G);
    p0_tables(F, 0); p0_tables(F, 1);
    stream_phase(F, F.ka->in.x, wsp<bf16_t>(F, WS_XN), wsp<float>(F, WS_SSQ));
}

__device__ __forceinline__ bf16x8 pack8(const f32x16& v, int base) {
    u32x4 w; w.x = pg8::cvt_pk_bf16(v[base + 0], v[base + 1]); w.y = pg8::cvt_pk_bf16(v[base + 2], v[base + 3]); w.z = pg8::cvt_pk_bf16(v[base + 4], v[base + 5]); w.w = pg8::cvt_pk_bf16(v[base + 6], v[base + 7]);
    return __builtin_bit_cast(bf16x8, w);
}
__device__ __forceinline__ void attn_unit(Frame& F, int layer, int b, int c) {
    const int h = F.wave, lane = F.lane, l31 = lane & 31, hi = lane >> 5;
    LAS float* btab = (LAS float*)(F.lds + TAB_OFF);
    LAS float* red = (LAS float*)(F.lds + TAB_OFF + 8448);
    const float* rb = F.ka->in.rel_bias + (size_t)layer * NHEAD * 257;
    for (int i = F.tid; i < NHEAD * 257; i += 512) { const int hh = i / 257, j = i - hh * 257; btab[hh * 260 + j] = rb[i] * LOG2E; }
    LDS_WAIT(); __syncthreads();
    const bf16_t* Qb = wsp<bf16_t>(F, WS_QK); const bf16_t* KC = wsp<bf16_t>(F, WS_KC); const bf16_t* VC = wsp<bf16_t>(F, WS_VT); bf16_t* MIX = wsp<bf16_t>(F, WS_MIX);
    const size_t tok0 = (size_t)b * SEQ + c * CHUNK;
    const LAS float* bt = btab + h * 260;
    LAS unsigned char* Kl = F.lds + h * 16384; LAS unsigned char* Vl = Kl + 8192;
    const unsigned cce = (unsigned)((lane & 7) ^ (lane >> 4)), cco = cce ^ 4u;
    const unsigned kl = (unsigned)(32 * (lane >> 5) + ((lane >> 3) & 3)) * 128u, vl = (unsigned)(lane >> 3) * 128u;
    unsigned ko[2], vo[2]; ko[0] = kl + 16u * cce; ko[1] = kl + 16u * cco; vo[0] = vl + 16u * cce; vo[1] = vl + 16u * cco;
    const char* Kg = (const char*)(KC + ((size_t)(b * NCH) * NHEAD + h) * 4096);
    const char* Vg = (const char*)(VC + ((size_t)(b * NCH) * NHEAD + h) * 4096);
    const unsigned kbase = (unsigned)__builtin_amdgcn_readfirstlane((int)(h * 16384)), vbase = kbase + 8192u;
    const __amdgpu_buffer_rsrc_t rW = __builtin_amdgcn_make_buffer_rsrc((void*)F.ws, 0, 0x7fffffff, 0x00020000);
    const unsigned kgo = (unsigned)__builtin_amdgcn_readfirstlane((int)(unsigned)(Kg - (const char*)F.ws)), vgo = (unsigned)__builtin_amdgcn_readfirstlane((int)(unsigned)(Vg - (const char*)F.ws));
#define ATT_DMA_K(cb_) do { const unsigned g_ = kgo + (unsigned)(c - 8 + (cb_)) * 65536u; _Pragma("unroll") for (int G = 0; G < 8; ++G) \
        __builtin_amdgcn_raw_ptr_buffer_load_lds(rW, (LAS void*)(F.lds + kbase + G * 1024), 16, (int)ko[G & 1], (int)(g_ + (unsigned)((16 * (G >> 2) + 4 * (G & 3)) * 128)), 0, 0); } while (0)
#define ATT_DMA_V(cb_) do { const unsigned g_ = vgo + (unsigned)(c - 8 + (cb_)) * 65536u; _Pragma("unroll") for (int G = 0; G < 8; ++G) \
        __builtin_amdgcn_raw_ptr_buffer_load_lds(rW, (LAS void*)(F.lds + vbase + G * 1024), 16, (int)vo[G & 1], (int)(g_ + (unsigned)(G * 1024)), 0, 0); } while (0)
    const int cbs = (c >= 8 ? 0 : 8 - c);
    const int swz = (l31 >> 1) & 7;
    const LAS unsigned char* krd = Kl + l31 * 128; const LAS unsigned char* vrd = Vl + l31 * 128;
    const float* gg = F.ka->in.g_group + (size_t)layer * D + h * HD;
    ATT_DMA_K(cbs); ATT_DMA_V(cbs);
    bf16x8 qf0[4];
    const bf16_t* q1p = Qb + (tok0 + 32 + l31) * 512 + h * HD + 32 * hi;
#pragma unroll
    for (int ks = 0; ks < 4; ++ks) qf0[ks] = *(const bf16x8*)(Qb + (tok0 + l31) * 512 + h * HD + 32 * hi + 8 * ks);
#pragma unroll
    for (int ks = 0; ks < 4; ++ks) asm volatile("" : "+v"(qf0[ks]));
    f32x16 o[2][2];
#pragma unroll
    for (int qt = 0; qt < 2; ++qt)
#pragma unroll
        for (int dt = 0; dt < 2; ++dt)
#pragma unroll
            for (int r = 0; r < 16; ++r) o[qt][dt][r] = 0.f;
    float mrun[2] = {-1e30f, -1e30f}, lrun[2] = {0.f, 0.f};
#pragma unroll 1
    for (int cb = cbs; cb <= 8; ++cb) {
        asm volatile("s_waitcnt vmcnt(8)" ::: "memory");
        bf16x8 kf[2][4];
#pragma unroll
        for (int t2 = 0; t2 < 2; ++t2)
#pragma unroll
            for (int ks = 0; ks < 4; ++ks) kf[t2][ks] = *(const LAS bf16x8*)(krd + t2 * 4096 + 16 * ((4 * hi + ks) ^ swz));
        bf16x8 q1[4];
#pragma unroll
        for (int ks = 0; ks < 4; ++ks) q1[ks] = *(const bf16x8*)(q1p + 8 * ks);
        asm volatile("s_waitcnt lgkmcnt(0)" ::: "memory");
        ATT_DMA_K(cb < 8 ? cb + 1 : 8);
        asm volatile("" ::: "memory");
        bf16x8 pf[2][4];
#pragma unroll
        for (int qt = 0; qt < 2; ++qt) {
            f32x16 s0, s1;
#pragma unroll
            for (int r = 0; r < 16; ++r) { s0[r] = 0.f; s1[r] = 0.f; }
#pragma unroll
            for (int ks = 0; ks < 4; ++ks) { const bf16x8 qq = qt ? q1[ks] : qf0[ks]; s0 = __builtin_amdgcn_mfma_f32_32x32x16_bf16(kf[0][ks], qq, s0, 0, 0, 0); s1 = __builtin_amdgcn_mfma_f32_32x32x16_bf16(kf[1][ks], qq, s1, 0, 0, 0); }
            float mx = -1e30f;
            if (cb <= 5) { const float cbias = bt[256];
#pragma unroll
                for (int r = 0; r < 16; ++r) { s0[r] += cbias; s1[r] += cbias; mx = fmaxf(mx, fmaxf(s0[r], s1[r])); }
            } else { const int rb0 = (8 - cb) * CHUNK + 32 * qt + l31 - 32 * hi;
#pragma unroll
                for (int r = 0; r < 16; ++r) { int i0 = rb0 - r; i0 = (i0 > 128 ? 128 : i0) + 128; int i1 = rb0 - 16 - r; i1 = (i1 > 128 ? 128 : i1) + 128;
                    s0[r] += bt[i0]; s1[r] += bt[i1]; mx = fmaxf(mx, fmaxf(s0[r], s1[r])); } }
            mx = fmaxf(mx, shx(mx, 32));
            const float mnew = fmaxf(mrun[qt], mx), alpha = fexp2(mrun[qt] - mnew); mrun[qt] = mnew;
            float ps = 0.f;
#pragma unroll
            for (int r = 0; r < 16; ++r) { s0[r] = fexp2(s0[r] - mnew); s1[r] = fexp2(s1[r] - mnew); ps += s0[r] + s1[r]; }
            lrun[qt] = lrun[qt] * alpha + ps;
#pragma unroll
            for (int r = 0; r < 16; ++r) { o[qt][0][r] *= alpha; o[qt][1][r] *= alpha; }
            pf[qt][0] = pack8(s0, 0); pf[qt][1] = pack8(s0, 8); pf[qt][2] = pack8(s1, 0); pf[qt][3] = pack8(s1, 8);
        }
        asm volatile("s_waitcnt vmcnt(8)" ::: "memory");
#pragma unroll
        for (int dt = 0; dt < 2; ++dt) {
            bf16x8 vf[4];
#pragma unroll
            for (int j = 0; j < 4; ++j) vf[j] = *(const LAS bf16x8*)(vrd + dt * 4096 + 16 * ((4 * hi + j) ^ swz));
#pragma unroll
            for (int j = 0; j < 4; ++j) { o[0][dt] = __builtin_amdgcn_mfma_f32_32x32x16_bf16(vf[j], pf[0][j], o[0][dt], 0, 0, 0); o[1][dt] = __builtin_amdgcn_mfma_f32_32x32x16_bf16(vf[j], pf[1][j], o[1][dt], 0, 0, 0); }
        }
        asm volatile("s_waitcnt lgkmcnt(0)" ::: "memory");
        ATT_DMA_V(cb < 8 ? cb + 1 : 8);
        asm volatile("" ::: "memory");
    }
#undef ATT_DMA_K
#undef ATT_DMA_V
#pragma unroll
    for (int qt = 0; qt < 2; ++qt) {
        const float lt = lrun[qt] + shx(lrun[qt], 32), inv = 1.0f / lt; float ss = 0.f;
#pragma unroll
        for (int dt = 0; dt < 2; ++dt)
#pragma unroll
            for (int r = 0; r < 16; ++r) { o[qt][dt][r] *= inv; ss += o[qt][dt][r] * o[qt][dt][r]; }
        ss += shx(ss, 32);
        if (hi == 0) red[h * 64 + 32 * qt + l31] = ss;
    }
    LDS_WAIT(); __syncthreads();
#pragma unroll
    for (int qt = 0; qt < 2; ++qt) {
        float tot = 0.f;
#pragma unroll
        for (int hh = 0; hh < NHEAD; ++hh) tot += red[hh * 64 + 32 * qt + l31];
        const float rstd = 1.0f / sqrtf(tot * (1.0f / D_ATTN) + EPS);
        bf16_t* orow = MIX + (tok0 + 32 * qt + l31) * 1024 + h * HD;
#pragma unroll
        for (int dt = 0; dt < 2; ++dt)
#pragma unroll
            for (int g4 = 0; g4 < 4; ++g4) { const int d0 = 32 * dt + 8 * g4 + 4 * hi; const f32x4 gv = *(const f32x4*)(gg + d0);
                u32x2 w; w.x = pg8::cvt_pk_bf16(o[qt][dt][4 * g4 + 0] * rstd * gv[0], o[qt][dt][4 * g4 + 1] * rstd * gv[1]); w.y = pg8::cvt_pk_bf16(o[qt][dt][4 * g4 + 2] * rstd * gv[2], o[qt][dt][4 * g4 + 3] * rstd * gv[3]);
                *(u32x2*)(orow + d0) = w; }
    }
    VM_WAIT(); __syncthreads();
}

constexpr int XCB_PITCH = 264;
__device__ __forceinline__ void rg1_unit(Frame& F, int layer, int b, int c) {
    const int tid = F.tid, lane = F.lane, l31 = lane & 31, hi = lane >> 5, w = F.wave;
    LAS float* XC = (LAS float*)F.lds;
    LAS bf16_t* XCB = (LAS bf16_t*)(F.lds + 65536);
    const bf16_t* RGS = wsp<bf16_t>(F, WS_RGS);
    const size_t tok0 = (size_t)b * SEQ + c * CHUNK;
    { const int ch = tid & 255, th = tid >> 8; const int tl0 = c * CHUNK + 32 * th;
        const float* cw = F.ka->in.rg_conv_w + (size_t)layer * 4 * D_RG; const float w0 = cw[ch], w1 = cw[D_RG + ch], w2 = cw[2 * D_RG + ch], w3 = cw[3 * D_RG + ch], cbv = F.ka->in.rg_conv_b[layer * D_RG + ch];
        const bf16_t* xp = RGS + ((size_t)b * SEQ + tl0) * 768 + ch;
        float xm3 = tl0 >= 3 ? bf2f(xp[-3 * 768]) : 0.f, xm2 = tl0 >= 2 ? bf2f(xp[-2 * 768]) : 0.f, xm1 = tl0 >= 1 ? bf2f(xp[-1 * 768]) : 0.f;
#pragma unroll 8
        for (int i = 0; i < 32; ++i) { const float x0 = bf2f(xp[(size_t)i * 768]); const float xc = w0 * xm3 + w1 * xm2 + w2 * xm1 + w3 * x0 + cbv;
            XC[(32 * th + i) * 256 + ch] = xc; XCB[(32 * th + i) * XCB_PITCH + ch] = (bf16_t)f2bf(xc); xm3 = xm2; xm2 = xm1; xm1 = x0; } }
    LDS_WAIT(); __syncthreads();
    const int hb = w >> 1, nt = w & 1, chn = hb * 64 + nt * 32 + l31;
    const unsigned char* tb = F.ws + WS_TAB + layer * TAB_L;
    const bf16_t* WXT = (const bf16_t*)(tb + TB_RGWX) + (size_t)(hb * 64 + nt * 32 + l31) * 64; const bf16_t* WAT = (const bf16_t*)(tb + TB_RGWA) + (size_t)(hb * 64 + nt * 32 + l31) * 64;
    const int trow = 16 * ((l31 >> 2) & 1) + 4 * (l31 >> 3) + (l31 & 3);
    f32x16 gxa[2], gaa[2];
#pragma unroll
    for (int tt = 0; tt < 2; ++tt)
#pragma unroll
        for (int r = 0; r < 16; ++r) { gxa[tt][r] = 0.f; gaa[tt][r] = 0.f; }
#pragma unroll
    for (int ks = 0; ks < 4; ++ks) { const bf16x8 bx = *(const bf16x8*)(WXT + 16 * ks + 8 * hi), ba = *(const bf16x8*)(WAT + 16 * ks + 8 * hi);
#pragma unroll
        for (int tt = 0; tt < 2; ++tt) { const bf16x8 a = *(const LAS bf16x8*)(XCB + (32 * tt + trow) * XCB_PITCH + hb * 64 + 16 * ks + 8 * hi);
            gxa[tt] = __builtin_amdgcn_mfma_f32_32x32x16_bf16(a, bx, gxa[tt], 0, 0, 0); gaa[tt] = __builtin_amdgcn_mfma_f32_32x32x16_bf16(a, ba, gaa[tt], 0, 0, 0); } }
    const float bxv = F.ka->in.rg_bx[layer * D_RG + chn], bav = F.ka->in.rg_ba[layer * D_RG + chn], lam = F.ka->in.rg_lambda[layer * D_RG + chn];
    const float c8 = -8.0f * log1pf(expf(-lam));
#pragma unroll
    for (int tt = 0; tt < 2; ++tt) { float P = 1.f, H = 0.f;
#pragma unroll
        for (int r = 0; r < 16; ++r) { const float xv = XC[(32 * tt + 16 * hi + r) * 256 + chn];
            const float gx = sigmoidf_(gxa[tt][r] + bxv), ga = sigmoidf_(gaa[tt][r] + bav);
            const float la = c8 * ga, x2 = 2.0f * la;
            const float a = 1.0f + la * (1.0f + la * (0.5f + la * (0.16666667f + la * (0.041666668f + la * 0.0083333338f))));
            const float mult = sqrtf(-x2 * (1.0f + x2 * (0.5f + x2 * (0.16666667f + x2 * (0.041666668f + x2 * 0.0083333338f)))));
            H = a * H + mult * gx * xv; P = a * P; gxa[tt][r] = H; gaa[tt][r] = P; } }
    float oP[2], oH[2];
#pragma unroll
    for (int tt = 0; tt < 2; ++tt) { oP[tt] = shx(gaa[tt][15], 32); oH[tt] = shx(gxa[tt][15], 32); }
    const float P0 = hi ? oP[0] : gaa[0][15], H0 = hi ? oH[0] : gxa[0][15], P1 = hi ? gaa[0][15] : oP[0], H1 = hi ? gxa[0][15] : oH[0];
    const float P2 = hi ? oP[1] : gaa[1][15], H2 = hi ? oH[1] : gxa[1][15], P3 = hi ? gaa[1][15] : oP[1], H3 = hi ? gxa[1][15] : oH[1];
    const float Pc2 = P0 * P1, Hc2 = P1 * H0 + H1, Pc3 = Pc2 * P2, Hc3 = P2 * Hc2 + H2, Pt = Pc3 * P3, Ht = P3 * Hc3 + H3;
    float Pc[2], Hc[2]; Pc[0] = hi ? P0 : 1.f; Hc[0] = hi ? H0 : 0.f; Pc[1] = hi ? Pc3 : Pc2; Hc[1] = hi ? Hc3 : Hc2;
    float* RGH = wsp<float>(F, WS_RGH); float* RGA = wsp<float>(F, WS_RGA);
#pragma unroll
    for (int tt = 0; tt < 2; ++tt)
#pragma unroll
        for (int r = 0; r < 16; ++r) { const size_t o = (tok0 + 32 * tt + 16 * hi + r) * 256 + chn; RGA[o] = Pc[tt] * gaa[tt][r]; RGH[o] = gaa[tt][r] * Hc[tt] + gxa[tt][r]; }
    if (hi == 0) { wsp<float>(F, WS_RGCP)[(size_t)(b * NCH + c) * 256 + chn] = Pt; wsp<float>(F, WS_RGCH)[(size_t)(b * NCH + c) * 256 + chn] = Ht; }
    __syncthreads();
}
__device__ __forceinline__ void rg3_unit(Frame& F, int layer, int b, int c) {
    const int tid = F.tid, ch = tid & 255, th = tid >> 8;
    LAS float* red = (LAS float*)F.lds;
    const float* CP = wsp<float>(F, WS_RGCP) + (size_t)b * NCH * 256 + ch; const float* CH = wsp<float>(F, WS_RGCH) + (size_t)b * NCH * 256 + ch;
    float Hs = 0.f;
    for (int j0 = 0; j0 < c; j0 += 16) { float cp[16], chv[16];
#pragma unroll
        for (int j = 0; j < 16; ++j) { const int jj = (j0 + j < c) ? j0 + j : c - 1; cp[j] = CP[jj * 256]; chv[j] = CH[jj * 256]; }
#pragma unroll
        for (int j = 0; j < 16; ++j) if (j0 + j < c) Hs = cp[j] * Hs + chv[j]; }
    const size_t tok0 = (size_t)b * SEQ + c * CHUNK + 32 * th;
    const float* RGH = wsp<float>(F, WS_RGH) + tok0 * 256 + ch; const float* RGA = wsp<float>(F, WS_RGA) + tok0 * 256 + ch; const bf16_t* GATE = wsp<bf16_t>(F, WS_RGS) + tok0 * 768 + 256 + ch;
    float y[32];
#pragma unroll
    for (int i = 0; i < 32; ++i) { const float hv = RGH[i * 256] + RGA[i * 256] * Hs; y[i] = hv * gelu_tanh(bf2f(GATE[(size_t)i * 768])); }
#pragma unroll
    for (int i = 0; i < 32; ++i) { const float s = wave_sum(y[i] * y[i]); if (F.lane == 0) red[(32 * th + i) * 4 + (F.wave & 3)] = s; }
    LDS_WAIT(); __syncthreads();
    const float gv = F.ka->in.g_group[(size_t)layer * D + 512 + ch];
    bf16_t* MIX = wsp<bf16_t>(F, WS_MIX) + tok0 * 1024 + 512 + ch;
#pragma unroll
    for (int i = 0; i < 32; ++i) { const f32x4 p = *(const LAS f32x4*)(red + (32 * th + i) * 4); const float rstd = 1.0f / sqrtf(((p[0] + p[1]) + (p[2] + p[3])) * (1.0f / D_RG) + EPS);
        MIX[(size_t)i * 1024] = (bf16_t)f2bf(y[i] * rstd * gv); }
    __syncthreads();
}

__device__ __forceinline__ void s5_stage_a(Frame& F, int g, int mt, LAS unsigned char* AP) {
    const int b = mt >> 1, c0 = 32 * (mt & 1);
    const bf16_t* US = wsp<bf16_t>(F, WS_RGS) + ((size_t)b * SEQ + c0 * CHUNK) * 768 + 512 + g * 16;
    u32x4 v[8];
#pragma unroll
    for (int j = 0; j < 8; ++j) { const int p = F.tid + 512 * j, hi = p & 1, sx = (p >> 1) & 63, i = p >> 7; v[j] = *(const u32x4*)(US + (size_t)(i * CHUNK + sx) * 768 + 8 * hi); }
#pragma unroll
    for (int j = 0; j < 8; ++j) { const int p = F.tid + 512 * j, hi = p & 1, sx = (p >> 1) & 63, i = p >> 7; *(LAS u32x4*)(AP + sx * 1024 + hi * 512 + i * 16) = v[j]; }
}
__device__ __forceinline__ void s5loc_unit(Frame& F, int layer, int g, int mt) {
    const int lane = F.lane, l31 = lane & 31, hi = lane >> 5, w = F.wave, ntile = w & 3, sh = w >> 2;
    LAS unsigned char* AP = F.lds;
    LAS float* xch = (LAS float*)(F.lds + 65536);
    const unsigned char* tb = F.ws + WS_TAB + layer * TAB_L;
    const bf16_t* WIN = (const bf16_t*)(tb + TB_WIN) + (size_t)(g * 128 + 32 * ntile + l31) * 1024 + 8 * hi + 32 * sh * 16;
    bf16x8 bb[32];
#pragma unroll
    for (int s = 0; s < 32; ++s) bb[s] = *(const bf16x8*)(WIN + s * 16);
    s5_stage_a(F, g, mt, AP);
    LDS_WAIT(); __syncthreads();
    f32x16 acc;
#pragma unroll
    for (int r = 0; r < 16; ++r) acc[r] = 0.f;
    const LAS unsigned char* ard = AP + (32 * sh) * 1024 + hi * 512 + l31 * 16;
#pragma unroll
    for (int s = 0; s < 32; ++s) { const bf16x8 a = *(const LAS bf16x8*)(ard + s * 1024); acc = __builtin_amdgcn_mfma_f32_32x32x16_bf16(a, bb[s], acc, 0, 0, 0); }
    if (sh == 1) {
#pragma unroll
        for (int r = 0; r < 16; ++r) xch[(ntile * 64 + lane) * 16 + r] = acc[r]; }
    LDS_WAIT(); __syncthreads();
    if (sh == 0) { float* SL = wsp<float>(F, WS_SLOC);
#pragma unroll
        for (int r = 0; r < 16; ++r) { const int row = (r & 3) + 8 * (r >> 2) + 4 * hi; SL[((size_t)(32 * mt + row) * S5G + g) * 128 + 32 * ntile + l31] = acc[r] + xch[(ntile * 64 + lane) * 16 + r]; } }
    __syncthreads();
}
constexpr int HS_PITCH = 136;
constexpr int S5Y_KM = 65536, S5Y_HS = S5Y_KM + 33280, S5Y_SLL = S5Y_HS + 8704;
static_assert(S5Y_SLL + 32768 <= MISC_OFF, "s5y LDS map");
__device__ __forceinline__ void s5y_unit(Frame& F, int layer, int g, int mt, int h2) {
    const int lane = F.lane, l31 = lane & 31, hi = lane >> 5, w = F.wave;
    LAS unsigned char* AP = F.lds;
    LAS unsigned char* KM = F.lds + S5Y_KM;
    LAS bf16_t* HS = (LAS bf16_t*)(F.lds + S5Y_HS);
    LAS float* SLL = (LAS float*)(F.lds + S5Y_SLL);
    const unsigned char* tb = F.ws + WS_TAB + layer * TAB_L;
    const int b = mt >> 1, c0 = 32 * (mt & 1), nchunk = c0 + 31;
    int jn[2]; jn[0] = 8 * h2 + w; jn[1] = 31 - jn[0];
    const bf16_t* WOUT = (const bf16_t*)(tb + TB_WOUT) + (size_t)g * 1024 * 128 + 8 * hi;
    bf16x8 wo[2][8];
#pragma unroll
    for (int q = 0; q < 2; ++q)
#pragma unroll
        for (int ks = 0; ks < 8; ++ks) wo[q][ks] = *(const bf16x8*)(WOUT + (size_t)(32 * jn[q] + l31) * 128 + 16 * ks);
    { const float* SL = wsp<float>(F, WS_SLOC) + ((size_t)(b * NCH) * S5G + g) * 128;
      f32x4 sv[4];
#pragma unroll
      for (int j = 0; j < 4; ++j) { const int idx = F.tid + 512 * j, cc = idx >> 5, q4 = idx & 31; sv[j] = (cc < nchunk) ? *(const f32x4*)(SL + (size_t)cc * S5G * 128 + 4 * q4) : (f32x4){0.f, 0.f, 0.f, 0.f}; }
      const bf16_t* KG = (const bf16_t*)(tb + TB_KMAT) + (size_t)g * 65 * 256;
      u32x4 kv[5];
#pragma unroll
      for (int j = 0; j < 5; ++j) { const int p = F.tid + 512 * j; kv[j] = (p < 65 * 32) ? *(const u32x4*)(KG + (size_t)p * 8) : (u32x4){0u, 0u, 0u, 0u}; }
      s5_stage_a(F, g, mt, AP);
#pragma unroll
      for (int j = 0; j < 4; ++j) { const int idx = F.tid + 512 * j, cc = idx >> 5, q4 = idx & 31; *(LAS f32x4*)(SLL + cc * 128 + 4 * q4) = sv[j]; }
#pragma unroll
      for (int j = 0; j < 5; ++j) { const int p = F.tid + 512 * j; if (p < 65 * 32) { const int li = p >> 5, co = (p >> 1) & 15, kh = p & 1; *(LAS u32x4*)(KM + li * 512 + kh * 256 + co * 16) = kv[j]; } }
    }
    LDS_WAIT(); __syncthreads();
    if (w == 0) { const float* APT = (const float*)(tb + TB_APT) + (g * S5P + lane) * 2; const float ar = APT[0], ai = APT[1];
        float hr = 0.f, hm = 0.f;
#pragma unroll 8
        for (int cc = 0; cc < c0 + 32; ++cc) {
            if (cc >= c0) { HS[(cc - c0) * HS_PITCH + lane] = (bf16_t)f2bf(hr); HS[(cc - c0) * HS_PITCH + 64 + lane] = (bf16_t)f2bf(hm); }
            const float sr = SLL[cc * 128 + lane], si = SLL[cc * 128 + 64 + lane];
            const float nr = ar * hr - ai * hm + sr, ni = ar * hm + ai * hr + si; hr = nr; hm = ni; } }
    LDS_WAIT(); __syncthreads();
    const int tl = l31 >> 4, co = l31 & 15;
    f32x16 acc[2];
#pragma unroll
    for (int q = 0; q < 2; ++q)
#pragma unroll
        for (int r = 0; r < 16; ++r) acc[q][r] = 0.f;
    const int smax = 2 * jn[1] + 1;
    const LAS unsigned char* ard = AP + hi * 512 + l31 * 16;
    const LAS unsigned char* krd = KM + hi * 256 + co * 16;
#pragma unroll 4
    for (int s = 0; s <= smax; ++s) { const bf16x8 a = *(const LAS bf16x8*)(ard + s * 1024);
#pragma unroll
        for (int q = 0; q < 2; ++q) if (s <= 2 * jn[q] + 1) { const int li = 2 * jn[q] + tl - s + 1; const bf16x8 bb = *(const LAS bf16x8*)(krd + li * 512);
            acc[q] = __builtin_amdgcn_mfma_f32_32x32x16_bf16(a, bb, acc[q], 0, 0, 0); } }
#pragma unroll
    for (int ks = 0; ks < 8; ++ks) { const bf16x8 a = *(const LAS bf16x8*)(HS + l31 * HS_PITCH + 16 * ks + 8 * hi);
#pragma unroll
        for (int q = 0; q < 2; ++q) acc[q] = __builtin_amdgcn_mfma_f32_32x32x16_bf16(a, wo[q][ks], acc[q], 0, 0, 0); }
    const int ch = g * 16 + co; const float dv = F.ka->in.s5_d[layer * D_S5 + ch];
    bf16_t* S5Y = wsp<bf16_t>(F, WS_S5Y);
    const LAS bf16_t* AP16 = (const LAS bf16_t*)AP;
#pragma unroll
    for (int q = 0; q < 2; ++q)
#pragma unroll
        for (int r = 0; r < 16; ++r) { const int row = (r & 3) + 8 * (r >> 2) + 4 * hi, t = 2 * jn[q] + tl; const size_t tok = (size_t)b * SEQ + (c0 + row) * CHUNK + t;
            const float uv = bf2f(AP16[t * 512 + (co >> 3) * 256 + row * 8 + (co & 7)]); S5Y[tok * 256 + ch] = (bf16_t)f2bf(gelu_tanh(acc[q][r] + dv * uv)); }
    __syncthreads();
}

__device__ __forceinline__ void r1_phase(Frame& F) {
    LAS float* rt = (LAS float*)F.lds;
    LAS int* cnt = (LAS int*)(F.lds + 32768);
    for (int i = F.tid; i < NE * D; i += 512) { const int e = i >> 10, k = i & 1023; rt[i] = F.ka->in.moe_router[k * NE + e]; }
    if (F.tid < NE) cnt[F.tid] = 0;
    LDS_WAIT(); __syncthreads();
    const int TPW = M / F.G, per_wave = TPW / NWAVES;
    const bf16_t* XS = wsp<bf16_t>(F, WS_XN); bf16_t* XNM = wsp<bf16_t>(F, WS_XNM); unsigned* TI = wsp<unsigned>(F, WS_TOKINFO);
    const GAS f32x4* gr = (const GAS f32x4*)(F.ka->in.norm_ffn_g + D) + F.lane;
    constexpr int TB = 2;
    for (int t0 = 0; t0 < per_wave; t0 += TB) {
        f32x4 v[TB][4]; float s[TB];
#pragma unroll
        for (int q = 0; q < TB; ++q) { const GAS u32x2* xr = (const GAS u32x2*)(XS + (size_t)(F.wg * TPW + F.wave * per_wave + t0 + q) * D) + F.lane;
#pragma unroll
            for (int j = 0; j < 4; ++j) { const u32x2 w = xr[64 * j]; v[q][j] = (f32x4){bflo(w.x), bfhi(w.x), bflo(w.y), bfhi(w.y)}; } }
#pragma unroll
        for (int q = 0; q < TB; ++q) { float a = 0.f;
#pragma unroll
            for (int j = 0; j < 4; ++j) a += (v[q][j].x * v[q][j].x + v[q][j].y * v[q][j].y) + (v[q][j].z * v[q][j].z + v[q][j].w * v[q][j].w);
            s[q] = a; }
#pragma unroll
        for (int o = 1; o < 64; o <<= 1)
#pragma unroll
            for (int q = 0; q < TB; ++q) s[q] += shx(s[q], o);
#pragma unroll
        for (int q = 0; q < TB; ++q) {
            const int tok = F.wg * TPW + F.wave * per_wave + t0 + q;
            const float rstd = 1.f / sqrtf(s[q] * (1.f / D) + EPS);
            GAS unsigned* o4 = (GAS unsigned*)((unsigned char*)XNM + (size_t)tok * D) + F.lane;
#pragma unroll
            for (int j = 0; j < 4; ++j) { const f32x4 gg = gr[64 * j]; v[q][j].x *= rstd * gg.x; v[q][j].y *= rstd * gg.y; v[q][j].z *= rstd * gg.z; v[q][j].w *= rstd * gg.w;
                o4[64 * j] = pg8::pk4_fp8(v[q][j].x, v[q][j].y, v[q][j].z, v[q][j].w); }
        }
        float lg[TB][NE];
#pragma unroll
        for (int e = 0; e < NE; ++e) {
#pragma unroll
            for (int j = 0; j < 4; ++j) { const f32x4 r = *(const LAS f32x4*)(rt + e * D + 256 * j + 4 * F.lane);
#pragma unroll
                for (int q = 0; q < TB; ++q) { const float a = (v[q][j].x * r.x + v[q][j].y * r.y) + (v[q][j].z * r.z + v[q][j].w * r.w); lg[q][e] = (j == 0) ? a : lg[q][e] + a; } } }
#pragma unroll
        for (int q = 0; q < TB; ++q) {
            const int ln = hw_lane();
            float a4[4], a2[2], a1;
            { const bool up = (ln & 32) != 0;
#pragma unroll
              for (int i = 0; i < 4; ++i) { const float keep = up ? lg[q][4 + i] : lg[q][i], give = up ? lg[q][i] : lg[q][4 + i]; a4[i] = keep + shx(give, 32); } }
            { const bool up = (ln & 16) != 0;
#pragma unroll
              for (int i = 0; i < 2; ++i) { const float keep = up ? a4[2 + i] : a4[i], give = up ? a4[i] : a4[2 + i]; a2[i] = keep + shx(give, 16); } }
            { const bool up = (ln & 8) != 0; const float keep = up ? a2[1] : a2[0], give = up ? a2[0] : a2[1]; a1 = keep + shx(give, 8); }
            a1 += shx(a1, 4); a1 += shx(a1, 2); a1 += shx(a1, 1);
#pragma unroll
            for (int e = 0; e < NE; ++e) lg[q][e] = __builtin_bit_cast(float, __builtin_amdgcn_ds_bpermute((8 * e) << 2, __builtin_bit_cast(int, a1)));
        }
#pragma unroll
        for (int q = 0; q < TB; ++q) {
            const int tok = F.wg * TPW + F.wave * per_wave + t0 + q;
            int i1 = 0; float l1 = lg[q][0];
#pragma unroll
            for (int e = 1; e < NE; ++e) if (lg[q][e] > l1) { l1 = lg[q][e]; i1 = e; }
            int i2 = -1; float l2 = -3.0e38f;
#pragma unroll
            for (int e = 0; e < NE; ++e) if (e != i1 && lg[q][e] > l2) { l2 = lg[q][e]; i2 = e; }
            const float g1 = 1.0f / (1.0f + expf(l2 - l1)), g2 = 1.0f - g1;
            if (F.lane == 0) { *(u32x4*)(TI + (size_t)tok * 4) = (u32x4){(unsigned)i1, (unsigned)i2, __float_as_uint(g1), __float_as_uint(g2)};
                __hip_atomic_fetch_add(&cnt[i1], 1, __ATOMIC_RELAXED, __HIP_MEMORY_SCOPE_WORKGROUP); __hip_atomic_fetch_add(&cnt[i2], 1, __ATOMIC_RELAXED, __HIP_MEMORY_SCOPE_WORKGROUP); }
        }
    }
    LDS_WAIT(); __syncthreads();
    if (F.tid < NE) __hip_atomic_store((unsigned*)F.ctl + CW_CNT + F.wg * NE + F.tid, (unsigned)cnt[F.tid], RLX_AGENT);
    __syncthreads();
}
__device__ __forceinline__ void r2_phase(Frame& F) {
    LAS int* sh = (LAS int*)F.lds;
    { const int e = F.tid & 7, part = (F.tid >> 3) & 7; int tot = 0, mine = 0;
      if (F.tid < 64) { const volatile unsigned* cp_ = (const volatile unsigned*)F.ctl + CW_CNT + e; int cv_[32];
          _Pragma("unroll") for (int q = 0; q < 32; ++q) cv_[q] = (int)((const unsigned*)cp_)[(part * 32 + q) * NE];
          _Pragma("unroll") for (int q = 0; q < 32; ++q) { tot += cv_[q]; if (part * 32 + q < F.wg) mine += cv_[q]; }
          sh[200 + F.tid] = tot; sh[264 + F.tid] = mine; } }
    LDS_WAIT(); __syncthreads();
    if (F.tid < NE) { int tot = 0, mine = 0; for (int part = 0; part < 8; ++part) { tot += sh[200 + part * 8 + F.tid]; mine += sh[264 + part * 8 + F.tid]; } sh[F.tid] = tot; sh[8 + F.tid] = mine; }
    LDS_WAIT(); __syncthreads();
    if (F.tid == 0) { int ps = 0; for (int e = 0; e < NE; ++e) { sh[16 + e] = ps; sh[24 + e] = ps + sh[8 + e]; ps += (sh[e] + 255) & ~255; } sh[160] = ps; }
    LDS_WAIT(); __syncthreads();
    const int TPW = M / F.G, NA = 2 * TPW;
    const unsigned* TI = wsp<unsigned>(F, WS_TOKINFO); int* POS = wsp<int>(F, WS_POS); int* ROWTOK = wsp<int>(F, WS_ROWTOK);
    int e_mine = 0;
    if (F.tid < NA) { e_mine = (int)TI[(size_t)(F.wg * TPW + (F.tid >> 1)) * 4 + (F.tid & 1)]; sh[32 + F.tid] = e_mine; }
    LDS_WAIT(); __syncthreads();
    if (F.tid < NA) { int rank = 0; for (int t = 0; t < F.tid; ++t) rank += (sh[32 + t] == e_mine) ? 1 : 0;
        const int pos = sh[24 + e_mine] + rank; const int tok = F.wg * TPW + (F.tid >> 1);
        POS[tok * 2 + (F.tid & 1)] = pos; ROWTOK[pos] = tok; }
    LDS_WAIT(); __syncthreads();
    if (F.wg == 0) {
        for (int e = 0; e < NE; ++e) { const int ps = sh[16 + e], tot = sh[e], pc = (tot + 255) & ~255;
            for (int p = ps + tot + F.tid; p < ps + pc; p += 512) ROWTOK[p] = 0;
            for (int t = ps / 256 + F.tid; t < (ps + pc) / 256; t += 512) __hip_atomic_store((unsigned*)F.ctl + CW_TILEE + t, (unsigned)e, RLX_AGENT); }
        if (F.tid == 0) __hip_atomic_store((unsigned*)F.ctl + CW_ROUTE + 16, (unsigned)(sh[160] / 256), RLX_AGENT);
    }
    __syncthreads();
}
__device__ __forceinline__ void combine_phase(Frame& F) {
    const int gw = F.wg * NWAVES + F.wave, NGW = F.G * NWAVES;
    const unsigned* TI = wsp<unsigned>(F, WS_TOKINFO); const int* POS = wsp<int>(F, WS_POS); const bf16_t* Y = wsp<bf16_t>(F, WS_YEXP);
    const GAS f32x4* gr = (const GAS f32x4*)F.ka->in.final_norm_g + F.lane;
    for (int tok = gw; tok < M; tok += NGW) {
        const u32x4 ti = *(const u32x4*)(TI + (size_t)tok * 4); const float g1 = __uint_as_float(ti.z), g2 = __uint_as_float(ti.w);
        const int p1 = POS[tok * 2], p2 = POS[tok * 2 + 1];
        GAS f32x4* xr = (GAS f32x4*)(F.out + (size_t)tok * D) + F.lane; const GAS u32x2* xs = (const GAS u32x2*)(wsp<bf16_t>(F, WS_XN) + (size_t)tok * D) + F.lane;
        const GAS u32x2* y1 = (const GAS u32x2*)(Y + (size_t)p1 * D) + F.lane; const GAS u32x2* y2 = (const GAS u32x2*)(Y + (size_t)p2 * D) + F.lane;
        f32x4 v[4]; float s = 0.f;
#pragma unroll
        for (int j = 0; j < 4; ++j) { const u32x2 w = xs[64 * j]; v[j] = (f32x4){bflo(w.x), bfhi(w.x), bflo(w.y), bfhi(w.y)}; const u32x2 a = y1[64 * j], b = y2[64 * j];
            v[j].x += g1 * bflo(a.x) + g2 * bflo(b.x); v[j].y += g1 * bfhi(a.x) + g2 * bfhi(b.x); v[j].z += g1 * bflo(a.y) + g2 * bflo(b.y); v[j].w += g1 * bfhi(a.y) + g2 * bfhi(b.y);
            s += (v[j].x * v[j].x + v[j].y * v[j].y) + (v[j].z * v[j].z + v[j].w * v[j].w); }
        const float rstd = 1.f / sqrtf(wave_sum(s) * (1.f / D) + EPS);
#pragma unroll
        for (int j = 0; j < 4; ++j) { const f32x4 gg = gr[64 * j]; xr[64 * j] = (f32x4){v[j].x * rstd * gg.x, v[j].y * rstd * gg.y, v[j].z * rstd * gg.z, v[j].w * rstd * gg.w}; }
    }
}

constexpr int NPHASE = 20;
#ifndef CODE_PF_BYTES
#define CODE_PF_BYTES 150000
#endif
__device__ __forceinline__ void code_prefetch(const char* pc0, int tid) {
    unsigned acc = 0; int t_ = tid; asm volatile("" : "+v"(t_));
    for (int off = t_ * 128; off < CODE_PF_BYTES; off += 512 * 128) acc += *(const volatile unsigned*)(pc0 + off);
    asm volatile("" :: "v"(acc));
}
typedef const __attribute__((address_space(4))) Args* KArgs;
#define NEWFRAME(F) Frame F; { KArgs ka_ = (KArgs)__builtin_amdgcn_kernarg_segment_ptr(); asm volatile("" : "+s"(ka_)); int wv_ = wave0_; asm volatile("" : "+s"(wv_)); int t_ = wv_ * 64 + hw_lane(); asm volatile("" : "+v"(t_)); \
    F.ka = ka_; F.lds = (LAS unsigned char*)lds_raw; F.ws = ka_->ws; F.ctl = (gu32*)(ka_->ws + WS_CTL); F.out = ka_->out; \
    F.tid = t_; F.lane = t_ & 63; F.wave = __builtin_amdgcn_readfirstlane(t_ >> 6); { int g_ = gridDim.x, w_ = blockIdx.x; { const unsigned vw_ = ((volatile LAS unsigned*)((LAS unsigned char*)lds_raw + MISC_OFF))[21]; if (vw_) w_ = __builtin_amdgcn_readfirstlane((int)vw_ - 1); } asm volatile("" : "+s"(g_), "+s"(w_)); F.G = g_; F.wg = w_; } }
__global__ void __launch_bounds__(NWAVES * 64, 2) fwd(Args args) {
    extern __shared__ __attribute__((aligned(16))) unsigned char lds_raw[];
    const char* pc0_ = (const char*)(((unsigned long long)__builtin_amdgcn_s_getpc()) & ~255ull);
    volatile LAS unsigned* MISC = (volatile LAS unsigned*)((LAS unsigned char*)lds_raw + MISC_OFF);
    const int wave0_ = __builtin_amdgcn_readfirstlane((int)threadIdx.x >> 6);
    { const int t0_ = wave0_ * 64 + hw_lane(); if (t0_ < 32) MISC[t0_] = 0u; }
    __syncthreads();
    if (CODE_PF_BYTES > 0) code_prefetch(pc0_, wave0_ * 64 + hw_lane());
    if (wave0_ == 0 && hw_lane() == 0) { MISC[16] = (unsigned)(unsigned long long)pc0_; MISC[17] = (unsigned)((unsigned long long)pc0_ >> 32); }
    if (args.ph_hi - args.ph_lo > 1) { (void)xcd_barrier_post((unsigned*)(args.ws + WS_CTL) + CW_BAR, MISC + 8, wave0_ == 0 && hw_lane() == 0); }
    __syncthreads();
#ifndef PHASE_MASK
#define PHASE_MASK 0xFFFFFu
#endif
#ifndef REP_MASK
#define REP_MASK 0x0u
#endif
#ifndef TIME_MASK
#define TIME_MASK 0x0u
#endif
#ifndef SUBREP_MASK
#define SUBREP_MASK 0u
#endif
#ifndef SUBTIME_MASK
#define SUBTIME_MASK 0x0u
#endif
#ifndef MIXA_MASK
#define MIXA_MASK 7
#endif
#ifndef SEAM_REPS
#define SEAM_REPS 1
#endif
#define TABP ((LAS int*)(F.lds + TAB_OFF))
#define SUBREP(k) for (int sr2_ = 0; sr2_ < 1 + (int)(((SUBREP_MASK) >> (k)) & 1u); ++sr2_)
#define STB(k) do { if (((SUBTIME_MASK) >> (k)) & 1u) tph2_ = __builtin_amdgcn_s_memrealtime(); } while (0)
#define STE(k) do { if (((SUBTIME_MASK) >> (k)) & 1u) { const unsigned long long n_ = __builtin_amdgcn_s_memrealtime(); const unsigned long long until_ = n_ + (n_ - tph2_); \
        while (__builtin_amdgcn_s_memrealtime() < until_) __builtin_amdgcn_s_sleep(8); } } while (0)
#pragma unroll 1
    for (int ph = args.ph_lo; ; ++ph) {
        int hi; { KArgs kh_ = (KArgs)__builtin_amdgcn_kernarg_segment_ptr(); asm volatile("" : "+s"(kh_)); hi = kh_->ph_hi; }
        if (ph >= hi) break;
        unsigned long long tph_ = 0, tph2_ = 0; (void)tph2_;
        const bool timed = (((TIME_MASK) >> ph) & 1u) != 0;
        if (timed) tph_ = __builtin_amdgcn_s_memrealtime();
        const int l = (ph >= 10) ? 1 : 0;
        const int ty = (ph >= 10 && ph <= 14) ? ph - 9 : ph;
        const int nrep = ((((PHASE_MASK) >> ph) & 1u) ? 1 : 0) + (int)(((REP_MASK) >> ph) & 1u);
#pragma unroll 1
        for (int rep_ = 0; rep_ < nrep; ++rep_) {
            switch (ty) {
            case 0: { NEWFRAME(F); p0_prologue(F); } break;
            case 1: {
                NEWFRAME(F);
                pg8::Gemm g{wsp<bf16_t>(F, WS_XN), wsp<bf16_t>(F, WS_WINT + l * WINT_L), D_IN, D, nullptr, nullptr, 0, F.ws, wsp<float>(F, WS_SSQ)};
                pg8::StaticOrder S; S.init(M / 256, D_IN, F.G, F.wg);
                pg8::EpiProj E{wsp<bf16_t>(F, WS_QK), wsp<bf16_t>(F, WS_KC), wsp<bf16_t>(F, WS_VT), wsp<bf16_t>(F, WS_RGS), (const LAS float*)(TABP + 16)};
                pg8::gemm_phase<pg8::EpiProj, true, false>(F.lds, TABP, g, S, E, F.wave);
                { NEWFRAME(F2); if (F2.G == 256 && F2.wg >= 64) { const int j0 = (l ? BG_D0 : BG_A0) + (F2.wg - 64) * 4; convert_jobs(F2, j0, j0 + 4, 1); } }
            } break;
            case 2: {
                NEWFRAME(F);
                const int vcu = (F.G % 8 == 0) ? (F.wg % 8) * (F.G / 8) + F.wg / 8 : F.wg;
                STB(0); if (MIXA_MASK & 1) SUBREP(0) for (int u = vcu; u < NUNIT; u += F.G) attn_unit(F, l, u >> 6, u & 63); STE(0);
                STB(1); if (MIXA_MASK & 2) SUBREP(1) for (int u = F.wg; u < NUNIT; u += F.G) rg1_unit(F, l, u >> 6, u & 63); STE(1);
                STB(2); if (MIXA_MASK & 4) SUBREP(2) for (int u = F.wg; u < S5G * 8; u += F.G) s5loc_unit(F, l, u >> 3, u & 7); STE(2);
                { NEWFRAME(F2); if (F2.G == 256 && F2.wg >= S5G * 8) { const int j0 = JOB_MOE0 + l * (BG_P0 / 2) + (F2.wg - S5G * 8) * 3; convert_jobs(F2, j0, j0 + 3, 1); } }
            } break;
            case 3: {
                NEWFRAME(F);
                STB(3); SUBREP(3) for (int u = F.wg; u < S5G * 16; u += F.G) s5y_unit(F, l, u >> 4, (u >> 1) & 7, u & 1); STE(3);
                STB(4); SUBREP(4) for (int u = F.wg; u < NUNIT; u += F.G) rg3_unit(F, l, u >> 6, u & 63); STE(4);
            } break;
            case 4: {
                NEWFRAME(F);
                pg8::StaticOrder S0; S0.init(M / 256, D, F.G, F.wg);
                pg8::Unit u0;
                if (S0.next(0, u0)) {
                    pg8::Gemm g{wsp<bf16_t>(F, WS_S5Y), wsp<bf16_t>(F, WS_TAB + l * TAB_L + TB_WGLU), 256, 256, nullptr, nullptr, 0, F.ws, nullptr};
                    pg8::OneUnit S{u0.pm};
                    pg8::EpiGLU E{wsp<bf16_t>(F, WS_S5Y), wsp<bf16_t>(F, WS_MIX) + 768, F.ka->in.g_group + (size_t)l * D + 768};
                    pg8::gemm_phase<pg8::EpiGLU, false, false>(F.lds, TABP, g, S, E, F.wave);
                }
                VM_WAIT(); __syncthreads();
            } break;
            case 5: case 8: {
                NEWFRAME(F);
                const bool dn = (ty == 8);
                pg8::Gemm g{dn ? wsp<bf16_t>(F, WS_ACT0) : wsp<bf16_t>(F, WS_MIX), dn ? wsp<bf16_t>(F, WS_F2) : wsp<bf16_t>(F, WS_WOUTT + l * WOUTT_L), D, dn ? FF : D, nullptr, nullptr, 0, F.ws, nullptr};
                pg8::StaticOrder S; S.init(M / 256, D, F.G, F.wg);
                pg8::EpiResid E{(!dn && l == 0) ? F.ka->in.x : nullptr, wsp<bf16_t>(F, WS_XN), wsp<bf16_t>(F, WS_XN), wsp<float>(F, WS_SSQ)};
                pg8::gemm_phase<pg8::EpiResid, true, false>(F.lds, TABP, g, S, E, F.wave);
            } break;
            case 7: {
                NEWFRAME(F);
                pg8::Gemm g{wsp<bf16_t>(F, WS_XN), wsp<bf16_t>(F, WS_F13), 2 * FF, D, nullptr, nullptr, 0, F.ws, wsp<float>(F, WS_SSQ)};
                pg8::StaticOrder S; S.init(M / 256, 2 * FF, F.G, F.wg);
                pg8::EpiSwiGLU E{wsp<bf16_t>(F, WS_ACT0), FF, (const LAS float*)(TABP + 16)};
                pg8::gemm_phase<pg8::EpiSwiGLU, true, false>(F.lds, TABP, g, S, E, F.wave);
                { NEWFRAME(F2); if (F2.G == 256 && F2.wg >= 128) { const int j0 = BG_C0 + (F2.wg - 128) * 4; convert_jobs(F2, j0, j0 + 4, 1); } }
            } break;
            case 15: { NEWFRAME(F); r1_phase(F); } break;
            case 16: { NEWFRAME(F); r2_phase(F); } break;
            case 17: {
                NEWFRAME(F);
                const int ntile = (int)__hip_atomic_load((unsigned*)F.ctl + CW_ROUTE + 16, RLX_AGENT);
                pg8::Gemm g{wsp<bf16_t>(F, WS_XNM), wsp<bf16_t>(F, WS_M13), 2 * FF, D, wsp<int>(F, WS_ROWTOK), (const int*)(F.ctl + CW_TILEE), E13, F.ws, nullptr};
                pg8::StaticOrder S; S.init(ntile, 2 * FF, F.G, F.wg);
                pg8::EpiSwiGLU8 E{F.ws + WS_ACT1};
                pg8::gemm_phase<pg8::EpiSwiGLU8, true, true, pg8::StaticOrder, 1>(F.lds, TABP, g, S, E, F.wave);
#ifndef NO_HOOK17
                { NEWFRAME(F2);
                  const int ntile2 = (int)__hip_atomic_load((unsigned*)F2.ctl + CW_ROUTE + 16, RLX_AGENT);
                  const int r = (ntile2 * (2 * FF / 256)) % F2.G, nlate = r ? F2.G - r : 0;
                  int covered = nlate * BG_F_PER; if (covered > JOB_END - JOB_W2) covered = JOB_END - JOB_W2;
                  if (r && F2.wg >= r) { const int j0 = JOB_W2 + (F2.wg - r) * BG_F_PER; int j1 = j0 + BG_F_PER; if (j1 > JOB_END) j1 = JOB_END; if (j0 < JOB_END) convert_jobs(F2, j0, j1, 1); }
                  convert_jobs(F2, JOB_W2 + covered + F2.wg, JOB_END, F2.G); }
#endif
            } break;
            case 18: {
                NEWFRAME(F);
                const int ntile = (int)__hip_atomic_load((unsigned*)F.ctl + CW_ROUTE + 16, RLX_AGENT);
                pg8::Gemm g{wsp<bf16_t>(F, WS_ACT1), wsp<bf16_t>(F, WS_M2), D, FF, nullptr, (const int*)(F.ctl + CW_TILEE), E2, F.ws, nullptr};
                pg8::StaticOrder S; S.init(ntile, D, F.G, F.wg);
                pg8::EpiBf16 E{wsp<bf16_t>(F, WS_YEXP), D};
                pg8::gemm_phase<pg8::EpiBf16, true, false, pg8::StaticOrder, 1>(F.lds, TABP, g, S, E, F.wave);
            } break;
            case 19: { NEWFRAME(F); combine_phase(F); } break;
            default: break;
            }
        }
        if (ph + 1 < hi && ph != 4 && ph != 13 && ph != 6 && ph != 9) {
            if (CODE_PF_BYTES > 0) { volatile LAS unsigned* MI_ = (volatile LAS unsigned*)((LAS unsigned char*)lds_raw + MISC_OFF); int wv2_ = wave0_; asm volatile("" : "+s"(wv2_)); code_prefetch((const char*)(((unsigned long long)MI_[17] << 32) | MI_[16]), wv2_ * 64 + hw_lane()); }
#pragma unroll 1
            for (int sr_ = 0; sr_ < SEAM_REPS; ++sr_) {
                KArgs kb_ = (KArgs)__builtin_amdgcn_kernarg_segment_ptr(); asm volatile("" : "+s"(kb_));
                XcdBarrier bar_; bar_.bar = (unsigned*)(kb_->ws + WS_CTL) + CW_BAR; bar_.x = xb_xcc_id(); bar_.st = (volatile LAS unsigned*)((LAS unsigned char*)lds_raw + MISC_OFF) + 8; { int wv3_ = wave0_; asm volatile("" : "+s"(wv3_)); bar_.leader = (wv3_ == 0 && hw_lane() == 0); } xcd_barrier(bar_); }
        }
        if (timed) { const unsigned long long n_ = __builtin_amdgcn_s_memrealtime(); const unsigned long long until_ = n_ + (n_ - tph_);
            while (__builtin_amdgcn_s_memrealtime() < until_) __builtin_amdgcn_s_sleep(8); }
    }
}

extern "C" void kernel_launch(void* const* d_in, const int* in_sizes, int n_in, void* d_out, int out_size, void* d_ws, size_t ws_size, hipStream_t stream) {
    static int grid = 0;
    if (grid == 0) {
        if (n_in != 31 || in_sizes[0] != M * D || out_size != M * D || ws_size < WS_END) { fprintf(stderr, "kernel_launch: unexpected problem: n_in %d in0 %d out %d ws %zu (need %zu)\n", n_in, n_in > 0 ? in_sizes[0] : -1, out_size, ws_size, (size_t)WS_END); grid = -1; return; }
        int dev = 0, cus = 0, per_cu = 0;
        if (hipGetDevice(&dev) != hipSuccess || hipDeviceGetAttribute(&cus, hipDeviceAttributeMultiprocessorCount, dev) != hipSuccess) { grid = -1; return; }
        if (hipFuncSetAttribute((const void*)fwd, hipFuncAttributeMaxDynamicSharedMemorySize, LDS_BYTES) != hipSuccess) { fprintf(stderr, "kernel_launch: hipFuncSetAttribute failed\n"); grid = -1; return; }
        if (hipOccupancyMaxActiveBlocksPerMultiprocessor(&per_cu, (const void*)fwd, NWAVES * 64, LDS_BYTES) != hipSuccess || per_cu < 1) { fprintf(stderr, "kernel_launch: occupancy query says %d blocks per CU\n", per_cu); grid = -1; (void)hipGetLastError(); return; }
        grid = cus;
        if (grid != 256) { fprintf(stderr, "kernel_launch: built for 256 CUs, found %d\n", cus); grid = -1; return; }
    }
    if (grid < 0) return;
    (void)hipMemsetAsync((char*)d_ws + WS_CTL, 0, CTL_ZERO_BYTES, stream);
    Args a{};
    const float** ip = (const float**)&a.in;
    for (int i = 0; i < 31; ++i) ip[i] = (const float*)d_in[i];
    a.out = (float*)d_out; a.ws = (unsigned char*)d_ws;
#if MK_N_LAUNCHES == 1
    a.ph_lo = 0; a.ph_hi = NPHASE;
    hipLaunchKernelGGL(fwd, dim3(grid), dim3(NWAVES * 64), LDS_BYTES, stream, a);
#else
    for (int p = 0; p < NPHASE; ++p) { a.ph_lo = p; a.ph_hi = p + 1; hipLaunchKernelGGL(fwd, dim3(grid), dim3(NWAVES * 64), LDS_BYTES, stream, a); }
#endif
}
```
